# Optimizing an MI355X kernel written in HIP

```python
import jax, jax.numpy as jnp
from jax import lax
import numpy as np

D_MODEL = 1024
BATCH = 2
SEQ = 8192
DEPTH = 1

N_HEADS = 8
HEAD_DIM = 64
N_KV = 2
D_ATTN = N_HEADS * HEAD_DIM
D_KV = N_KV * HEAD_DIM
N_GM_GROUPS = 8
GM_GROUP_DIM = 64
D_GM = N_GM_GROUPS * GM_GROUP_DIM
D_MIX = D_ATTN + D_GM
SPLIT_SIZES = (D_ATTN, D_KV, D_KV, D_KV, D_KV, D_KV, D_KV, 3 * N_HEADS, D_GM, D_GM)
D_IN = D_ATTN + 6 * D_KV + 3 * N_HEADS + 2 * D_GM
CMP_LEN = 32
CMP_STRIDE = 16
CMP_HIDDEN = 128
SEL_BLOCK = 64
N_SEL = 16
WINDOW = 512
Q_BLOCK = 128
FORCE_BONUS = 1.0e4
GM_CHUNK = 128
N_EXPERTS = 32
TOP_K = 4
D_EXPERT = 1024
SWIGLU_LIMIT = 7.0
SWIGLU_ALPHA = 1.702
MOE_BLOCK = 128

EPS = 1e-6
NEG = -1.0e30

kernel_name = "hymba_nsa_gmlp_moe_layer"


def rmsnorm(x, g):
    xf = x.astype(jnp.float32)
    r = lax.rsqrt(jnp.mean(xf * xf, axis=-1, keepdims=True) + EPS)
    return (xf * r).astype(x.dtype) * g


def masked_softmax(s, mask):
    s = jnp.where(mask, s.astype(jnp.float32), NEG)
    p = jax.nn.softmax(s, axis=-1)
    return jnp.where(mask, p, 0.0)


def alibi_slopes(n_heads):
    return jnp.exp2(-8.0 * jnp.arange(1, n_heads + 1, dtype=jnp.float32) / n_heads)


def compress(kv, pos_emb, w1, b1, w2, b2):
    B, G, T, DH = kv.shape
    seg = kv.reshape(B, G, T // CMP_STRIDE, CMP_STRIDE, DH)
    r = CMP_LEN // CMP_STRIDE
    nc = T // CMP_STRIDE - r + 1
    blocks = jnp.concatenate([seg[:, :, i:i + nc] for i in range(r)], axis=3)
    flat = (blocks + pos_emb).reshape(B, G, nc, CMP_LEN * DH)
    hid = jax.nn.gelu(flat @ w1 + b1)
    return hid @ w2 + b2


def block_overlap(nc, ns):
    c0 = jnp.arange(nc)[:, None] * CMP_STRIDE
    n0 = jnp.arange(ns)[None, :] * SEL_BLOCK
    ov = jnp.clip(jnp.minimum(c0 + CMP_LEN, n0 + SEL_BLOCK) - jnp.maximum(c0, n0), 0, None)
    return ov.astype(jnp.float32) / CMP_LEN


def nsa_attention(q, kc, vc, ks, vs, kw, vw, gates):
    B, H, T, DH = q.shape
    G = ks.shape[1]
    R = H // G
    NC = kc.shape[2]
    NS = T // SEL_BLOCK
    n_sel = min(N_SEL, NS)
    scale = DH ** -0.5
    slopes = alibi_slopes(H).reshape(G, R, 1, 1)
    c_end = jnp.arange(NC) * CMP_STRIDE + CMP_LEN - 1
    overlap = block_overlap(NC, NS)
    n_start = jnp.arange(NS) * SEL_BLOCK
    ks_blocks = ks.reshape(B, G, NS, SEL_BLOCK, DH)
    vs_blocks = vs.reshape(B, G, NS, SEL_BLOCK, DH)
    pad = ((0, 0), (0, 0), (WINDOW, 0), (0, 0))
    kw_pad = jnp.pad(kw, pad)
    vw_pad = jnp.pad(vw, pad)
    b_ix = jnp.arange(B)[:, None, None, None]
    g_ix = jnp.arange(G)[None, :, None, None]
    in_block = jnp.arange(SEL_BLOCK)
    win_off = jnp.arange(WINDOW + Q_BLOCK) - WINDOW

    def one_block(q0):
        t = q0 + jnp.arange(Q_BLOCK)
        qg = lax.dynamic_slice_in_dim(q, q0, Q_BLOCK, axis=2).reshape(B, G, R, Q_BLOCK, DH)
        gt = lax.dynamic_slice_in_dim(gates, q0, Q_BLOCK, axis=2).reshape(B, G, R, Q_BLOCK, 3)
        dist_c = t[:, None] - c_end[None, :]
        s = jnp.einsum('bgrqd,bgcd->bgrqc', qg, kc) * scale - slopes * dist_c.astype(jnp.float32)
        p_cmp = masked_softmax(s, dist_c >= 0)
        o_cmp = jnp.einsum('bgrqc,bgcd->bgrqd', p_cmp.astype(vc.dtype), vc)
        imp = jnp.einsum('bgrqc,cn->bgqn', p_cmp, overlap)
        forced = (n_start[None, :] == (t[:, None] // SEL_BLOCK) * SEL_BLOCK) | (n_start[None, :] == 0)
        imp = jnp.where(forced, imp + FORCE_BONUS, imp)
        imp = jnp.where(n_start[None, :] <= t[:, None], imp, NEG)
        _, idx = lax.top_k(imp, n_sel)
        k_g = ks_blocks[b_ix, g_ix, idx].reshape(B, G, Q_BLOCK, n_sel * SEL_BLOCK, DH)
        v_g = vs_blocks[b_ix, g_ix, idx].reshape(B, G, Q_BLOCK, n_sel * SEL_BLOCK, DH)
        pos = (idx[..., None] * SEL_BLOCK + in_block).reshape(B, G, Q_BLOCK, n_sel * SEL_BLOCK)
        dist_s = (t[None, None, :, None] - pos)[:, :, None]
        s = jnp.einsum('bgrqd,bgqkd->bgrqk', qg, k_g) * scale - slopes * dist_s.astype(jnp.float32)
        p = masked_softmax(s, dist_s >= 0)
        o_sel = jnp.einsum('bgrqk,bgqkd->bgrqd', p.astype(v_g.dtype), v_g)
        k_w = lax.dynamic_slice_in_dim(kw_pad, q0, WINDOW + Q_BLOCK, axis=2)
        v_w = lax.dynamic_slice_in_dim(vw_pad, q0, WINDOW + Q_BLOCK, axis=2)
        pos_w = q0 + win_off
        dist_w = t[:, None] - pos_w[None, :]
        mask_w = (dist_w >= 0) & (dist_w < WINDOW) & (pos_w[None, :] >= 0)
        s = jnp.einsum('bgrqd,bgkd->bgrqk', qg, k_w) * scale - slopes * dist_w.astype(jnp.float32)
        p = masked_softmax(s, mask_w)
        o_win = jnp.einsum('bgrqk,bgkd->bgrqd', p.astype(v_w.dtype), v_w)
        o = gt[..., 0:1] * o_cmp + gt[..., 1:2] * o_sel + gt[..., 2:3] * o_win
        return o.reshape(B, H, Q_BLOCK, DH)

    out = lax.map(one_block, jnp.arange(T // Q_BLOCK) * Q_BLOCK)
    return out.transpose(1, 0, 3, 2, 4).reshape(B, T, H * DH)


def spatial_gating(u, v, v_gain, w_s, b_s):
    B, T, _ = u.shape
    u = jax.nn.gelu(u)
    v = rmsnorm(jax.nn.gelu(v), v_gain)
    vc = v.reshape(B, T // GM_CHUNK, GM_CHUNK, N_GM_GROUPS, GM_GROUP_DIM)
    ws = w_s * jnp.tril(jnp.ones((GM_CHUNK, GM_CHUNK), w_s.dtype))
    y = jnp.einsum('gts,bcsgd->bctgd', ws, vc) + b_s.T[None, None, :, :, None]
    return u * y.reshape(B, T, D_GM)


def moe(x, w_router, b_router, w_gate_up, b_gate_up, w_down, b_down):
    B, T, D = x.shape
    N = B * T
    xt = x.reshape(N, D)
    logits = (xt @ w_router + b_router).astype(jnp.float32)
    top_val, top_idx = lax.top_k(logits, TOP_K)
    gate = jax.nn.softmax(top_val, axis=-1)
    S = N * TOP_K
    e_flat = top_idx.reshape(S)
    tok_flat = jnp.repeat(jnp.arange(N, dtype=jnp.int32), TOP_K)
    g_flat = gate.reshape(S)
    order = jnp.argsort(e_flat)
    e_s, tok_s, g_s = e_flat[order], tok_flat[order], g_flat[order]
    counts = jnp.bincount(e_flat, length=N_EXPERTS)
    padded = ((counts + MOE_BLOCK - 1) // MOE_BLOCK) * MOE_BLOCK
    pad_end = jnp.cumsum(padded)
    pad_start = pad_end - padded
    cnt_start = jnp.cumsum(counts) - counts
    dest = pad_start[e_s] + jnp.arange(S) - cnt_start[e_s]
    P = ((S + MOE_BLOCK - 1) // MOE_BLOCK) * MOE_BLOCK + N_EXPERTS * MOE_BLOCK
    NB = P // MOE_BLOCK
    tok_buf = jnp.full((P,), N, dtype=jnp.int32).at[dest].set(tok_s)
    g_buf = jnp.zeros((P,), jnp.float32).at[dest].set(g_s)
    blk_expert = jnp.minimum(jnp.searchsorted(pad_end, jnp.arange(NB) * MOE_BLOCK, side='right'), N_EXPERTS - 1)
    x_pad = jnp.concatenate([xt, jnp.zeros((1, D), xt.dtype)], axis=0)

    def expert_block(args):
        e, tok, g = args
        xb = x_pad[tok]
        h = xb @ w_gate_up[e] + b_gate_up[e]
        h_glu = jnp.minimum(h[:, 0::2], SWIGLU_LIMIT)
        h_lin = jnp.clip(h[:, 1::2], -SWIGLU_LIMIT, SWIGLU_LIMIT)
        a = h_glu * jax.nn.sigmoid(SWIGLU_ALPHA * h_glu) * (h_lin + 1.0)
        return ((a @ w_down[e] + b_down[e]) * g[:, None]).astype(x.dtype)

    out = lax.map(expert_block, (blk_expert, tok_buf.reshape(NB, MOE_BLOCK), g_buf.reshape(NB, MOE_BLOCK)))
    y = jnp.zeros((N + 1, D), x.dtype).at[tok_buf].add(out.reshape(P, D))
    return y[:N].reshape(B, T, D)


def setup_inputs(seed: int = 0) -> dict:
    key = jax.random.key(seed)
    ks = jax.random.split(key, 23)
    f = jnp.float32

    def nrm(k, shape, scale):
        return jax.random.normal(k, shape, f) * scale

    def gain(k, shape):
        return 1.0 + 0.01 * jax.random.normal(k, shape, f)

    return {
        "x": nrm(ks[0], (BATCH, SEQ, D_MODEL), 1.0),
        "norm1_g": gain(ks[1], (D_MODEL,)),
        "w_in": nrm(ks[2], (D_MODEL, D_IN), D_MODEL ** -0.5),
        "q_norm_g": gain(ks[3], (HEAD_DIM,)),
        "k_norm_g": gain(ks[4], (3, HEAD_DIM)),
        "cmp_pos": nrm(ks[5], (2, CMP_LEN, HEAD_DIM), 0.02),
        "w_cmp1": nrm(ks[6], (2, CMP_LEN * HEAD_DIM, CMP_HIDDEN), (CMP_LEN * HEAD_DIM) ** -0.5),
        "b_cmp1": nrm(ks[7], (2, CMP_HIDDEN), 0.01),
        "w_cmp2": nrm(ks[8], (2, CMP_HIDDEN, HEAD_DIM), CMP_HIDDEN ** -0.5),
        "b_cmp2": nrm(ks[9], (2, HEAD_DIM), 0.01),
        "gm_v_norm_g": gain(ks[10], (D_GM,)),
        "gm_w_s": nrm(ks[11], (N_GM_GROUPS, GM_CHUNK, GM_CHUNK), GM_CHUNK ** -0.5),
        "gm_b_s": gain(ks[12], (N_GM_GROUPS, GM_CHUNK)),
        "out_norm_attn_g": gain(ks[13], (D_ATTN,)),
        "out_norm_gm_g": gain(ks[14], (D_GM,)),
        "w_out": nrm(ks[15], (D_MIX, D_MODEL), D_MIX ** -0.5),
        "norm2_g": gain(ks[16], (D_MODEL,)),
        "w_router": nrm(ks[17], (D_MODEL, N_EXPERTS), D_MODEL ** -0.5),
        "b_router": nrm(ks[18], (N_EXPERTS,), 0.01),
        "w_gate_up": nrm(ks[19], (N_EXPERTS, D_MODEL, 2 * D_EXPERT), D_MODEL ** -0.5),
        "b_gate_up": nrm(ks[20], (N_EXPERTS, 2 * D_EXPERT), 0.01),
        "w_down": nrm(ks[21], (N_EXPERTS, D_EXPERT, D_MODEL), D_EXPERT ** -0.5),
        "b_down": nrm(ks[22], (N_EXPERTS, D_MODEL), 0.01),
    }


def reference(x, norm1_g, w_in, q_norm_g, k_norm_g, cmp_pos, w_cmp1, b_cmp1, w_cmp2, b_cmp2,
              gm_v_norm_g, gm_w_s, gm_b_s, out_norm_attn_g, out_norm_gm_g, w_out, norm2_g,
              w_router, b_router, w_gate_up, b_gate_up, w_down, b_down):
    B, T, _ = x.shape

    def heads(a, n):
        return a.reshape(B, T, n, HEAD_DIM).transpose(0, 2, 1, 3)

    for _layer in range(DEPTH):
        h = rmsnorm(x, norm1_g)
        z = h @ w_in
        split_at = np.cumsum(SPLIT_SIZES)[:-1].tolist()
        zq, zkc, zvc, zks, zvs, zkw, zvw, zg, zu, zv = jnp.split(z, split_at, axis=-1)
        q = rmsnorm(heads(zq, N_HEADS), q_norm_g)
        kc = rmsnorm(compress(heads(zkc, N_KV), cmp_pos[0], w_cmp1[0], b_cmp1[0], w_cmp2[0], b_cmp2[0]), k_norm_g[0])
        vc = compress(heads(zvc, N_KV), cmp_pos[1], w_cmp1[1], b_cmp1[1], w_cmp2[1], b_cmp2[1])
        k_sel = rmsnorm(heads(zks, N_KV), k_norm_g[1])
        k_win = rmsnorm(heads(zkw, N_KV), k_norm_g[2])
        gates = jax.nn.sigmoid(zg).reshape(B, T, N_HEADS, 3).transpose(0, 2, 1, 3)
        o_attn = nsa_attention(q, kc, vc, k_sel, heads(zvs, N_KV), k_win, heads(zvw, N_KV), gates)
        o_gm = spatial_gating(zu, zv, gm_v_norm_g, gm_w_s, gm_b_s)
        mixed = jnp.concatenate([rmsnorm(o_attn, out_norm_attn_g), rmsnorm(o_gm, out_norm_gm_g)], axis=-1)
        x = x + mixed @ w_out
        x = x + moe(rmsnorm(x, norm2_g), w_router, b_router, w_gate_up, b_gate_up, w_down, b_down)
    return x
```

```cpp
#define MK_SPLIT 1
#include <hip/hip_runtime.h>
#include <cstdio>
#include <cstdint>

#define LAS __attribute__((address_space(3)))
#define GAS __attribute__((address_space(1)))
typedef unsigned short bf16;
typedef short bf16x8 __attribute__((ext_vector_type(8)));
typedef short s16x4 __attribute__((ext_vector_type(4)));
typedef float f32x4 __attribute__((ext_vector_type(4)));
typedef float f32x2 __attribute__((ext_vector_type(2)));
typedef float f32x16 __attribute__((ext_vector_type(16)));
typedef unsigned u32x4 __attribute__((ext_vector_type(4)));
typedef unsigned u32x2 __attribute__((ext_vector_type(2)));
typedef __bf16 bf16x2_t __attribute__((ext_vector_type(2)));
typedef GAS unsigned gu32;

#define DI __device__ __forceinline__
DI unsigned pk2(float lo, float hi) { f32x2 v = {lo, hi}; bf16x2_t b = __builtin_convertvector(v, bf16x2_t); return __builtin_bit_cast(unsigned, b); }
DI int lane_id() { return (int)__builtin_amdgcn_mbcnt_hi(~0u, __builtin_amdgcn_mbcnt_lo(~0u, 0u)); }
DI float bf2f(unsigned short x) { return __uint_as_float((unsigned)x << 16); }
DI float bflo(unsigned w) { return __uint_as_float(w << 16); }
DI float bfhi(unsigned w) { return __uint_as_float(w & 0xffff0000u); }
DI float wave_sum(float v) {
#pragma unroll
    for (int o = 1; o < 64; o <<= 1) v += __shfl_xor(v, o);
    return v;
}
DI float gelu_tanh(float x) {
    const float u = x * (1.0f + 0.044715f * x * x);
    return x * __builtin_amdgcn_rcpf(1.0f + __builtin_amdgcn_exp2f(-2.3022082f * u));
}
DI float sigmoidf_(float x) { return __builtin_amdgcn_rcpf(1.0f + __builtin_amdgcn_exp2f(-1.44269504f * x)); }

namespace pg8 {
constexpr int BM = 256, BK = 64, HALF = 128, HTB = HALF * BK * 2, STAGE_BYTES = 8 * HTB, NXCD = 8, WGM = 8;
__host__ __device__ __forceinline__ int lds_byte(int r, int c) { const int st = (r >> 4) * 2 + (c >> 5), rr = r & 15, cc = c & 31, ob = rr * 64 + cc * 2; return st * 1024 + (ob ^ (((ob >> 9) & 1) << 5)); }
__host__ __device__ __forceinline__ void stage_rc(int b, int& R, int& C) { const int st = b / 1024, sb = b % 1024, swz = sb ^ (((sb >> 9) & 1) << 5); R = (st >> 1) * 16 + swz / 64; C = (st & 1) * 32 + (swz % 64) / 2; }
__host__ __device__ __forceinline__ int perm32(int rho) { const int n = rho >> 4, i = rho & 15; return 8 * (i >> 2) + 4 * n + (i & 3); }

struct Unit { int pm, pn, e, ml, cnt; };
struct Src { const char* a; const char* b; unsigned ao[2][2]; };

template <class Epi, class Sched, bool ALIGN_EPI>
__device__ __forceinline__ void gemm_phase(LAS unsigned char* lds, const int K, const Sched& S, const Epi& E, const int wid) {
    const int lane = lane_id(), tid = wid * 64 + lane, wr = wid >> 2, wc = wid & 3, fr = lane & 15, fq = lane >> 4;
    const int nt = K / BK;
    unsigned voffB[2];
#pragma unroll
    for (int i = 0; i < 2; ++i) { int R, C; stage_rc(tid * 16 + i * 8192, R, C); const int Rb = Epi::PERM ? ((R & ~31) + perm32(R & 31)) : R;
        voffB[i] = (unsigned)(Rb * K + C) * 2u; }
    const size_t kstep = (size_t)(BK * 2);
    const size_t hstep = (size_t)HALF * K * 2;
    const unsigned ldsw = (unsigned)wid * 1024u;
    const int aoff = lds_byte(wr * 64 + fr, fq * 8), boff = lds_byte(wc * 32 + fr, fq * 8);
#define PG8_SA(b, h) (((b) * 2 + (h)) * HTB)
#define PG8_SB(b, h) ((4 + (b) * 2 + (h)) * HTB)
#define PG8_GLDS(src, dstoff) __builtin_amdgcn_global_load_lds((const unsigned*)(src), (LAS unsigned*)(lds + (dstoff)), 16, 0, 0)
#define PG8_STAGE_B(bufoff, gbase) do { _Pragma("unroll") for (int _i = 0; _i < 2; ++_i) PG8_GLDS((const char*)(gbase) + voffB[_i], (bufoff) + ldsw + _i * 8192); } while (0)
#define PG8_STAGE_A(bufoff, gbase, o0, o1) do { PG8_GLDS((const char*)(gbase) + (o0), (bufoff) + ldsw); PG8_GLDS((const char*)(gbase) + (o1), (bufoff) + ldsw + 8192); } while (0)
#define PG8_LDA(dst, b, h) do { _Pragma("unroll") for (int m = 0; m < 4; ++m) _Pragma("unroll") for (int k = 0; k < 2; ++k) dst[m][k] = *(const LAS bf16x8*)(lds + PG8_SA(b, h) + aoff + m * 2048 + k * 1024); } while (0)
#define PG8_LDB(dst, b, h) do { _Pragma("unroll") for (int n = 0; n < 2; ++n) _Pragma("unroll") for (int k = 0; k < 2; ++k) dst[n][k] = *(const LAS bf16x8*)(lds + PG8_SB(b, h) + boff + n * 2048 + k * 1024); } while (0)
#define PG8_MMA(ai, bj, At, Bt) do { __builtin_amdgcn_s_setprio(1); _Pragma("unroll") for (int m = 0; m < 4; ++m) _Pragma("unroll") for (int n = 0; n < 2; ++n) _Pragma("unroll") for (int k = 0; k < 2; ++k) \
        acc[ai][bj][m][n] = __builtin_amdgcn_mfma_f32_16x16x32_bf16(Bt[n][k], At[m][k], acc[ai][bj][m][n], 0, 0, 0); __builtin_amdgcn_s_setprio(0); } while (0)
#define PG8_WAIT_V(n) asm volatile("s_waitcnt vmcnt(" #n ")" ::: "memory")
#define PG8_WAIT_L(n) asm volatile("s_waitcnt lgkmcnt(" #n ")" ::: "memory")
#define PG8_BAR __builtin_amdgcn_s_barrier()
#define PG8_SCHED __builtin_amdgcn_sched_barrier(0)
    Unit cur, nxt; int ui = 0;
    if (!S.next(0, cur)) return;
    Src sc, sn;
    S.fill(cur, sc, tid);
    f32x4 acc[2][2][4][2];
#pragma unroll
    for (int a = 0; a < 2; ++a)
#pragma unroll
        for (int b = 0; b < 2; ++b)
#pragma unroll
            for (int m = 0; m < 4; ++m)
#pragma unroll
                for (int n = 0; n < 2; ++n) acc[a][b][m][n] = (f32x4){0.f, 0.f, 0.f, 0.f};
    bf16x8 At[4][2], B0[2][2], B1[2][2];
    PG8_STAGE_B(PG8_SB(0, 0), sc.b); PG8_STAGE_B(PG8_SB(0, 1), sc.b + hstep); PG8_STAGE_A(PG8_SA(0, 0), sc.a, sc.ao[0][0], sc.ao[0][1]); PG8_STAGE_A(PG8_SA(0, 1), sc.a, sc.ao[1][0], sc.ao[1][1]);
    if (wr == 1) PG8_BAR;
    PG8_WAIT_V(2); PG8_BAR;
    PG8_STAGE_B(PG8_SB(1, 0), sc.b + kstep); PG8_STAGE_A(PG8_SA(1, 0), sc.a + kstep, sc.ao[0][0], sc.ao[0][1]); PG8_STAGE_B(PG8_SB(1, 1), sc.b + hstep + kstep);
    PG8_WAIT_V(6); PG8_BAR;
    for (;;) {
        const bool has_next = S.next(ui + 1, nxt);
        if (has_next) S.fill(nxt, sn, tid); else sn = sc;
        if constexpr (Sched::GATHER) { *(LAS u32x4*)(S.stash + tid * 16) = (u32x4){sn.ao[0][0], sn.ao[0][1], sn.ao[1][0], sn.ao[1][1]}; }
        for (int t = 0; t < nt; t += 2) {
            const bool last = (t == nt - 2);
            const char* a1 = sc.a + (size_t)(t + 1) * kstep;
            const char* a2 = last ? sn.a : sc.a + (size_t)(t + 2) * kstep; const char* b2 = last ? sn.b : sc.b + (size_t)(t + 2) * kstep;
            const char* a3 = a2 + kstep; const char* b3 = b2 + kstep;
            unsigned o00, o01, o10, o11;
            if constexpr (Sched::GATHER) { o00 = sc.ao[0][0]; o01 = sc.ao[0][1]; o10 = sc.ao[1][0]; o11 = sc.ao[1][1];
                if (last) { const u32x4 q = *(const LAS u32x4*)(S.stash + tid * 16); o00 = q.x; o01 = q.y; o10 = q.z; o11 = q.w; } }
            else { o00 = sc.ao[0][0]; o01 = sc.ao[0][1]; o10 = sc.ao[1][0]; o11 = sc.ao[1][1]; }
            PG8_LDB(B0, 0, 0); PG8_LDB(B1, 0, 1); PG8_SCHED; PG8_LDA(At, 0, 0); PG8_STAGE_A(PG8_SA(1, 1), a1, sc.ao[1][0], sc.ao[1][1]);
            PG8_WAIT_V(8); PG8_WAIT_L(0); PG8_BAR; PG8_MMA(0, 0, At, B0); PG8_MMA(0, 1, At, B1); PG8_BAR; PG8_SCHED;
            PG8_LDA(At, 0, 1); PG8_STAGE_B(PG8_SB(0, 0), b2); PG8_STAGE_B(PG8_SB(0, 1), b2 + hstep); PG8_STAGE_A(PG8_SA(0, 0), a2, o00, o01);
            PG8_WAIT_V(8); PG8_WAIT_L(0); PG8_BAR; PG8_MMA(1, 0, At, B0); PG8_MMA(1, 1, At, B1); PG8_BAR; PG8_SCHED;
            PG8_LDB(B0, 1, 0); PG8_LDB(B1, 1, 1); PG8_SCHED; PG8_LDA(At, 1, 0); PG8_STAGE_A(PG8_SA(0, 1), a2, o10, o11);
            PG8_WAIT_V(8); PG8_WAIT_L(0); PG8_BAR; PG8_MMA(0, 0, At, B0); PG8_MMA(0, 1, At, B1); PG8_BAR; PG8_SCHED;
            PG8_LDA(At, 1, 1); PG8_STAGE_B(PG8_SB(1, 0), b3); PG8_STAGE_B(PG8_SB(1, 1), b3 + hstep); PG8_STAGE_A(PG8_SA(1, 0), a3, o00, o01);
            PG8_WAIT_V(8); PG8_WAIT_L(0); PG8_BAR; PG8_MMA(1, 0, At, B0); PG8_MMA(1, 1, At, B1); PG8_BAR; PG8_SCHED;
        }
        if constexpr (ALIGN_EPI) { if (wr == 0) PG8_BAR; }
        E(acc, cur, wr, wc, fr, fq);
        if (!has_next) break;
#pragma unroll
        for (int a = 0; a < 2; ++a)
#pragma unroll
            for (int b = 0; b < 2; ++b)
#pragma unroll
                for (int m = 0; m < 4; ++m)
#pragma unroll
                    for (int n = 0; n < 2; ++n) acc[a][b][m][n] = (f32x4){0.f, 0.f, 0.f, 0.f};
        cur = nxt; sc.a = sn.a; sc.b = sn.b;
        if constexpr (Sched::GATHER) { const u32x4 q = *(const LAS u32x4*)(S.stash + tid * 16); sc.ao[0][0] = q.x; sc.ao[0][1] = q.y; sc.ao[1][0] = q.z; sc.ao[1][1] = q.w; }
        ++ui;
        if constexpr (ALIGN_EPI) { if (wr == 1) PG8_BAR; }
    }
    PG8_WAIT_V(0);
    if constexpr (!ALIGN_EPI) { if (wr == 0) PG8_BAR; }
    PG8_BAR;
#undef PG8_SA
#undef PG8_SB
#undef PG8_GLDS
#undef PG8_STAGE_A
#undef PG8_STAGE_B
#undef PG8_LDA
#undef PG8_LDB
#undef PG8_MMA
#undef PG8_WAIT_V
#undef PG8_WAIT_L
#undef PG8_BAR
#undef PG8_SCHED
}
}

#define XB_TMO      128
#define XB_XCNT(j)  (256  + 64 * (j))
#define XB_XSUB(j)  (1280 + 64 * (j))
#define XB_XGEN(j)  (2304 + 64 * (j))
#define XB_TOP      3328
#define XB_TOPGEN   3392
#define XCD_BAR_WORDS 3456
#define XB_SPIN_CAP (1u << 20)
DI unsigned xb_ld(unsigned* p)              { return __hip_atomic_load(p, __ATOMIC_RELAXED, __HIP_MEMORY_SCOPE_AGENT); }
DI unsigned xb_add(unsigned* p, unsigned v) { return __hip_atomic_fetch_add(p, v, __ATOMIC_RELAXED, __HIP_MEMORY_SCOPE_AGENT); }
DI unsigned xb_xcc_id() { return (unsigned)__builtin_amdgcn_s_getreg((3 << 11) | 20) & 0xFu; }
#define XB_SPIN(cond, bar) do { unsigned _sp = 0; while (cond) { __builtin_amdgcn_s_sleep(1); \
    if ((++_sp & 255u) == 0u) { if (xb_ld(&(bar)[XB_TMO])) break; if (_sp > XB_SPIN_CAP) { atomicAdd(&(bar)[XB_TMO], 1u); break; } } } } while (0)
struct XcdBarrier { unsigned* bar; unsigned x; volatile LAS unsigned* st; };
DI XcdBarrier xcd_barrier_post(unsigned* bar, volatile LAS unsigned* st, bool t0) {
    XcdBarrier b; b.bar = bar; b.x = xb_xcc_id(); b.st = st;
    if (t0) (void)xb_add(&bar[XB_XCNT(b.x)], 1u);
    return b;
}
DI void xcd_barrier_complete(unsigned* bar, unsigned x, unsigned& nloc, unsigned& nx) {
    const unsigned G = gridDim.x * gridDim.y * gridDim.z;
    unsigned sum, cnt, mine, sp = 0u;
    for (;;) {
        sum = 0u; cnt = 0u; mine = 0u;
#pragma unroll
        for (unsigned j = 0; j < 16; ++j) { const unsigned c = xb_ld(&bar[XB_XCNT(j)]); sum += c; cnt += (c > 0u) ? 1u : 0u; mine = (j == x) ? c : mine; }
        if (sum == G) break;
        __builtin_amdgcn_s_sleep(1);
        if ((++sp & 255u) == 0u) { if (xb_ld(&bar[XB_TMO])) break; if (sp > XB_SPIN_CAP) { atomicAdd(&bar[XB_TMO], 1u); break; } }
    }
    nloc = mine > 0u ? mine : 1u; nx = cnt > 0u ? cnt : 1u;
}
DI void xcd_barrier(const XcdBarrier& b, bool t0) {
    asm volatile("s_waitcnt vmcnt(0)" ::: "memory");
    __syncthreads();
    if (t0) {
        unsigned* bar = b.bar;
        __builtin_amdgcn_s_waitcnt(0);
        unsigned nloc = b.st[0], nx = b.st[1];
        if (nloc == 0u) { xcd_barrier_complete(bar, b.x, nloc, nx); b.st[0] = nloc; b.st[1] = nx; }
        const unsigned old = xb_add(&bar[XB_XSUB(b.x)], 1u);
        const unsigned gen = old / nloc;
        if (old + 1u == (gen + 1u) * nloc) {
            __builtin_amdgcn_fence(__ATOMIC_RELEASE, "agent");
            asm volatile("s_waitcnt vmcnt(0)" ::: "memory");
            const unsigned og = xb_add(&bar[XB_TOP], 1u);
            const unsigned tg = og / nx;
            if (og + 1u == (tg + 1u) * nx) xb_add(&bar[XB_TOPGEN], 1u);
            else XB_SPIN(xb_ld(&bar[XB_TOPGEN]) == tg, bar);
            __builtin_amdgcn_fence(__ATOMIC_ACQUIRE, "agent");
            xb_add(&bar[XB_XGEN(b.x)], 1u);
            asm volatile("s_waitcnt vmcnt(0)" ::: "memory");
        } else {
            XB_SPIN(xb_ld(&bar[XB_XGEN(b.x)]) == gen, bar);
            __builtin_amdgcn_fence(__ATOMIC_ACQUIRE, "agent");
            asm volatile("s_waitcnt vmcnt(0)" ::: "memory");
        }
    }
    __syncthreads();
}

constexpr int NWAVES = 8;
constexpr int BATCH = 2, T = 8192, D = 1024, M = BATCH * T;
constexpr int NZP = 2560;
constexpr int NEXP = 32, DEXP = 1024;
constexpr int PMAX = M * 4 + NEXP * 256;
constexpr float EPS = 1e-6f;
constexpr float LOG2E = 1.4426950408889634f;
constexpr float QSCALE = 0.125f * LOG2E;

constexpr size_t MiB = 1u << 20;
constexpr size_t WS_CTL = 0, CTL_ZERO_BYTES = 1 * MiB;
constexpr int CW_BAR = 4096;
constexpr int CW_CNT = 8192;
constexpr size_t WS_VSSQ = 256 * 1024;
constexpr size_t WS_WIN = 2 * MiB, WS_WOUT = 8 * MiB, WS_WCMP = 10 * MiB, WS_C1 = 11 * MiB, WS_RINV2 = 11 * MiB + 65536;
constexpr size_t WS_GATES = 12 * MiB, WS_KCN = 14 * MiB, WS_VCC = 14 * MiB + 512 * 1024, WS_TOKINFO = 15 * MiB, WS_TGATE = 15 * MiB + 512 * 1024;
constexpr size_t WS_LIST = 16 * MiB, WS_TCMP = 20 * MiB, WS_KCH = 24 * MiB, WS_VCH = 28 * MiB;
constexpr size_t WS_KS = 32 * MiB, WS_VS = 36 * MiB, WS_KW = 40 * MiB, WS_VW = 44 * MiB, WS_Q = 48 * MiB, WS_U = 64 * MiB, WS_VG = 80 * MiB;
constexpr size_t WS_XN = 96 * MiB, WS_MIXED = 128 * MiB, WS_WGU = 160 * MiB, WS_WD = 288 * MiB, WS_H = 352 * MiB, WS_O2 = 496 * MiB, WS_END = 640 * MiB;

constexpr int RING_BYTES = 131072;
constexpr int LDS_BYTES = 163840;
constexpr int MISC_OFF = LDS_BYTES - 512;
constexpr int AUX_OFF = 147456;

struct Frame {
    LAS unsigned char* lds; volatile LAS unsigned* MISC; gu32* ctl;
    int wave, vcu, G;
    float* out; unsigned char* ws;
    const __attribute__((address_space(4))) char* ka;
};
typedef const __attribute__((address_space(4))) char* kptr_t;
DI const float* fin(const Frame& F, int i) { kptr_t ka = F.ka; asm volatile("" : "+s"(ka)); return *(const float* const __attribute__((address_space(4)))*)(ka + 8 * i); }

struct StaticOrder {
    static constexpr bool GATHER = false;
    int nM, nN, nwg, G, c, K; const char* A; const char* B;
    DI void init(const void* A_, const void* B_, int M_, int N_, int K_, int G_, int c_) { A = (const char*)A_; B = (const char*)B_; nM = M_ / 256; nN = N_ / 256; nwg = nM * nN; G = G_; c = c_; K = K_; }
    DI bool next(int i, pg8::Unit& u) const {
        const long L = (long)i * G + c; if (L >= nwg) return false;
        int wgid = (int)L; { const int q = nwg / 8, r = nwg % 8, xcd = wgid % 8, off = wgid / 8; wgid = (xcd < r ? xcd * (q + 1) : r * (q + 1) + (xcd - r) * q) + off; }
        const int nig = 8 * nN, gid = wgid / nig, fm = gid * 8, gsz = (nM - fm) < 8 ? (nM - fm) : 8;
        u.pm = fm + ((wgid % nig) % gsz); u.pn = (wgid % nig) / gsz; u.e = 0; u.ml = 0; u.cnt = 0; return true;
    }
    DI void fill(const pg8::Unit& u, pg8::Src& s, int tid) const {
        int RA[2]; unsigned CA2[2];
        for (int i = 0; i < 2; ++i) { int R, C; pg8::stage_rc(tid * 16 + i * 8192, R, C); RA[i] = R; CA2[i] = (unsigned)C * 2u; }
        const size_t tstep = (size_t)256 * K * 2;
        s.a = A + (size_t)u.pm * tstep; s.b = B + (size_t)u.pn * tstep;
#pragma unroll
        for (int h = 0; h < 2; ++h)
#pragma unroll
            for (int i = 0; i < 2; ++i) s.ao[h][i] = (unsigned)((h * 128 + RA[i]) * K) * 2u + CA2[i];
    }
};
struct CmpOrder {
    static constexpr bool GATHER = false;
    int idx; const char* A0; const char* A1; const char* B;
    DI bool next(int i, pg8::Unit& u) const { if (i > 0 || idx < 0 || idx >= 16) return false; u.e = idx >> 3; u.pm = idx & 7; u.pn = 0; u.ml = 0; u.cnt = 0; return true; }
    DI void fill(const pg8::Unit& u, pg8::Src& s, int tid) const {
        int RA[2]; unsigned CA2[2];
        for (int i = 0; i < 2; ++i) { int R, C; pg8::stage_rc(tid * 16 + i * 8192, R, C); RA[i] = R; CA2[i] = (unsigned)C * 2u; }
        const size_t tstep = (size_t)256 * 1024 * 2;
        s.a = (u.e ? A1 : A0) + (size_t)u.pm * tstep; s.b = B + (size_t)u.e * tstep;
#pragma unroll
        for (int h = 0; h < 2; ++h)
#pragma unroll
            for (int i = 0; i < 2; ++i) s.ao[h][i] = (unsigned)((h * 128 + RA[i]) * 1024) * 2u + CA2[i];
    }
};
template <int NT, bool GATH> struct MoeOrder {
    static constexpr bool GATHER = GATH;
    int G, c, utot; const LAS int* tstart; const LAS int* ecnt; const char* A; const char* B; size_t bexp; const int* list; LAS unsigned char* stash;
    DI bool next(int i, pg8::Unit& u) const {
        const int L = i * G + c; if (L >= utot) return false;
        const int nt = L % NT, tau = L / NT; int e = 0;
        while (e < 31 && tstart[e + 1] <= tau) ++e;
        u.pm = tau; u.pn = nt; u.e = e; u.ml = tau - tstart[e]; u.cnt = ecnt[e]; return true;
    }
    DI void fill(const pg8::Unit& u, pg8::Src& s, int tid) const {
        int RA[2]; unsigned CA2[2];
        for (int i = 0; i < 2; ++i) { int R, C; pg8::stage_rc(tid * 16 + i * 8192, R, C); RA[i] = R; CA2[i] = (unsigned)C * 2u; }
        const size_t tstep = (size_t)256 * 1024 * 2;
        s.b = B + (size_t)u.e * bexp + (size_t)u.pn * tstep;
        if constexpr (GATH) {
            s.a = A;
#pragma unroll
            for (int h = 0; h < 2; ++h)
#pragma unroll
                for (int i = 0; i < 2; ++i) { const int r = u.ml * 256 + h * 128 + RA[i]; int tok = list[((size_t)u.e * M + r) * 2]; tok = (r < u.cnt) ? tok : 0; s.ao[h][i] = (unsigned)tok * 2048u + CA2[i]; }
        } else {
            s.a = A + (size_t)u.pm * tstep;
#pragma unroll
            for (int h = 0; h < 2; ++h)
#pragma unroll
                for (int i = 0; i < 2; ++i) s.ao[h][i] = (unsigned)((h * 128 + RA[i]) * 1024) * 2u + CA2[i];
        }
    }
};

struct EpiWin {
    static constexpr bool PERM = true;
    bf16 *Q, *KCH, *VCH, *KS, *VS, *KW, *VW, *U, *VG; float *GATES, *vssq; const float *qg, *kg;
    DI void operator()(const f32x4 (&acc)[2][2][4][2], const pg8::Unit& u, int wr, int wc, int fr, int fq) const {
        const int hu = u.pn * 4 + wc;
        if (hu > 36) return;
        const int rowb = u.pm * 256 + wr * 64 + fr;
        int kind; bf16* dst = nullptr; bool tokmajor = true; int sub = 0; const float* gain = nullptr; float gsc = 1.f;
        if (hu < 8) { kind = 0; dst = Q; sub = hu; gain = qg; gsc = QSCALE; }
        else if (hu < 20) { const int w = (hu - 8) >> 1; sub = (hu - 8) & 1; tokmajor = false;
            if (w == 0) { kind = 1; dst = KCH; } else if (w == 1) { kind = 1; dst = VCH; } else if (w == 2) { kind = 0; dst = KS; gain = kg + 64; }
            else if (w == 3) { kind = 1; dst = VS; } else if (w == 4) { kind = 0; dst = KW; gain = kg + 128; } else { kind = 1; dst = VW; } }
        else if (hu < 28) { kind = 2; dst = U; sub = hu - 20; }
        else if (hu < 36) { kind = 3; dst = VG; sub = hu - 28; }
        else kind = 4;
        float gv[2][8];
        if (kind == 0) {
#pragma unroll
            for (int bj = 0; bj < 2; ++bj)
#pragma unroll
                for (int i = 0; i < 8; ++i) gv[bj][i] = gain[32 * bj + 8 * fq + i] * gsc;
        }
#pragma unroll
        for (int ai = 0; ai < 2; ++ai)
#pragma unroll
            for (int m = 0; m < 4; ++m) {
                const int row = rowb + ai * 128 + m * 16;
                float x[2][8];
#pragma unroll
                for (int bj = 0; bj < 2; ++bj)
#pragma unroll
                    for (int n = 0; n < 2; ++n)
#pragma unroll
                        for (int i = 0; i < 4; ++i) x[bj][4 * n + i] = acc[ai][bj][m][n][i];
                if (kind == 4) {
                    if (fq < 3) {
                        f32x4 a, b;
#pragma unroll
                        for (int i = 0; i < 4; ++i) { a[i] = sigmoidf_(x[0][i]); b[i] = sigmoidf_(x[0][4 + i]); }
                        *(f32x4*)(GATES + (size_t)row * 24 + 8 * fq) = a; *(f32x4*)(GATES + (size_t)row * 24 + 8 * fq + 4) = b;
                    }
                    continue;
                }
                if (kind == 0) {
                    float s = 0.f;
#pragma unroll
                    for (int bj = 0; bj < 2; ++bj)
#pragma unroll
                        for (int i = 0; i < 8; ++i) s += x[bj][i] * x[bj][i];
                    s += __shfl_xor(s, 16); s += __shfl_xor(s, 32);
                    const float rinv = __builtin_amdgcn_rsqf(s * (1.0f / 64.0f) + EPS);
#pragma unroll
                    for (int bj = 0; bj < 2; ++bj)
#pragma unroll
                        for (int i = 0; i < 8; ++i) x[bj][i] = x[bj][i] * rinv * gv[bj][i];
                } else if (kind >= 2) {
#pragma unroll
                    for (int bj = 0; bj < 2; ++bj)
#pragma unroll
                        for (int i = 0; i < 8; ++i) x[bj][i] = gelu_tanh(x[bj][i]);
                    if (kind == 3) {
                        float s = 0.f;
#pragma unroll
                        for (int bj = 0; bj < 2; ++bj)
#pragma unroll
                            for (int i = 0; i < 8; ++i) s += x[bj][i] * x[bj][i];
                        s += __shfl_xor(s, 16); s += __shfl_xor(s, 32);
                        if (fq == 0) atomicAdd(vssq + row, s);
                    }
                }
                const size_t off = tokmajor ? ((size_t)row * 512 + sub * 64) : ((size_t)(row + ((row >> 13) + sub) * 8192) * 64);
#pragma unroll
                for (int bj = 0; bj < 2; ++bj) {
                    u32x4 w; w.x = pk2(x[bj][0], x[bj][1]); w.y = pk2(x[bj][2], x[bj][3]); w.z = pk2(x[bj][4], x[bj][5]); w.w = pk2(x[bj][6], x[bj][7]);
                    *(u32x4*)(dst + off + 32 * bj + 8 * fq) = w;
                }
            }
    }
};
struct EpiCmp {
    static constexpr bool PERM = false;
    float* Tc;
    DI void operator()(const f32x4 (&acc)[2][2][4][2], const pg8::Unit& u, int wr, int wc, int fr, int fq) const {
        float* base = Tc + (size_t)u.e * 2048 * 256;
#pragma unroll
        for (int ai = 0; ai < 2; ++ai)
#pragma unroll
            for (int m = 0; m < 4; ++m) { const int row = u.pm * 256 + ai * 128 + wr * 64 + m * 16 + fr;
#pragma unroll
                for (int bj = 0; bj < 2; ++bj)
#pragma unroll
                    for (int n = 0; n < 2; ++n) *(f32x4*)(base + (size_t)row * 256 + bj * 128 + wc * 32 + n * 16 + 4 * fq) = acc[ai][bj][m][n]; }
    }
};
struct EpiWout {
    static constexpr bool PERM = false;
    const float* x; float* out; bf16* X1B;
    DI void operator()(const f32x4 (&acc)[2][2][4][2], const pg8::Unit& u, int wr, int wc, int fr, int fq) const {
#pragma unroll
        for (int ai = 0; ai < 2; ++ai)
#pragma unroll
            for (int m = 0; m < 4; ++m) { const size_t row = (size_t)u.pm * 256 + ai * 128 + wr * 64 + m * 16 + fr;
#pragma unroll
                for (int bj = 0; bj < 2; ++bj)
#pragma unroll
                    for (int n = 0; n < 2; ++n) { const size_t o = row * 1024 + u.pn * 256 + bj * 128 + wc * 32 + n * 16 + 4 * fq;
                        const f32x4 v = *(const f32x4*)(x + o) + acc[ai][bj][m][n]; *(f32x4*)(out + o) = v;
                        u32x2 w; w.x = pk2(v[0], v[1]); w.y = pk2(v[2], v[3]); *(u32x2*)(X1B + o) = w; } }
    }
};
struct EpiG1 {
    static constexpr bool PERM = true;
    bf16* H; const float* bias; const int* list;
    DI void operator()(const f32x4 (&acc)[2][2][4][2], const pg8::Unit& u, int wr, int wc, int fr, int fq) const {
        const float* bb = bias + (size_t)u.e * 2048 + u.pn * 256 + wc * 32 + 8 * fq;
        f32x4 bv[2][2];
#pragma unroll
        for (int bj = 0; bj < 2; ++bj)
#pragma unroll
            for (int n = 0; n < 2; ++n) bv[bj][n] = *(const f32x4*)(bb + bj * 128 + 4 * n);
        const int* lp = list + ((size_t)u.e * M + u.ml * 256 + wr * 64 + fr) * 2 + 1;
#pragma unroll
        for (int ai = 0; ai < 2; ++ai)
#pragma unroll
            for (int m = 0; m < 4; ++m) { const int rl = ai * 128 + wr * 64 + m * 16 + fr;
                const float rinv = __int_as_float(lp[(ai * 128 + m * 16) * 2]);
                bf16* hp = H + ((size_t)u.pm * 256 + rl) * 1024 + u.pn * 128 + wc * 16 + 4 * fq;
#pragma unroll
                for (int bj = 0; bj < 2; ++bj) { float a[4];
#pragma unroll
                    for (int n = 0; n < 2; ++n) { const f32x4 v = acc[ai][bj][m][n] * rinv + bv[bj][n];
#pragma unroll
                        for (int q = 0; q < 2; ++q) { const float gl = fminf(v[2 * q], 7.0f), li = fminf(fmaxf(v[2 * q + 1], -7.0f), 7.0f);
                            a[2 * n + q] = gl * __builtin_amdgcn_rcpf(1.0f + __builtin_amdgcn_exp2f(-1.702f * LOG2E * gl)) * (li + 1.0f); } }
                    u32x2 w; w.x = pk2(a[0], a[1]); w.y = pk2(a[2], a[3]); *(u32x2*)(hp + bj * 64) = w; } }
    }
};
struct EpiG2 {
    static constexpr bool PERM = true;
    bf16* O2; const float* bias;
    DI void operator()(const f32x4 (&acc)[2][2][4][2], const pg8::Unit& u, int wr, int wc, int fr, int fq) const {
        const float* bb = bias + (size_t)u.e * 1024 + u.pn * 256 + wc * 32 + 8 * fq;
        f32x4 bv[2][2];
#pragma unroll
        for (int bj = 0; bj < 2; ++bj)
#pragma unroll
            for (int n = 0; n < 2; ++n) bv[bj][n] = *(const f32x4*)(bb + bj * 128 + 4 * n);
#pragma unroll
        for (int ai = 0; ai < 2; ++ai)
#pragma unroll
            for (int m = 0; m < 4; ++m) { const int rl = ai * 128 + wr * 64 + m * 16 + fr;
                bf16* op = O2 + ((size_t)u.pm * 256 + rl) * 1024 + u.pn * 256 + wc * 32 + 8 * fq;
#pragma unroll
                for (int bj = 0; bj < 2; ++bj) { const f32x4 v0 = acc[ai][bj][m][0] + bv[bj][0], v1 = acc[ai][bj][m][1] + bv[bj][1];
                    u32x4 w; w.x = pk2(v0[0], v0[1]); w.y = pk2(v0[2], v0[3]); w.z = pk2(v1[0], v1[1]); w.w = pk2(v1[2], v1[3]); *(u32x4*)(op + bj * 128) = w; } }
    }
};

#define LDS_WAIT() asm volatile("s_waitcnt lgkmcnt(0)" ::: "memory")
template <class SC, class KSC>
DI void p0_item(const float* W, int Nsrc, bf16* WT, int K, int prow0, int k0, SC srccol, KSC kscale, LAS float* scr, int lane) {
    const int sc = srccol(prow0 + (lane & 31));
#pragma unroll 8
    for (int i = 0; i < 32; ++i) { const int kk = 2 * i + (lane >> 5); float v = 0.f; if (sc >= 0) v = W[(size_t)(k0 + kk) * Nsrc + sc] * kscale(k0 + kk); scr[kk * 33 + (lane & 31)] = v; }
    LDS_WAIT(); asm volatile("" ::: "memory");
    const int c = lane & 7;
#pragma unroll
    for (int j = 0; j < 4; ++j) { const int n = (lane >> 3) + 8 * j; const LAS float* s = scr + (8 * c) * 33 + n;
        u32x4 o; o.x = pk2(s[0 * 33], s[1 * 33]); o.y = pk2(s[2 * 33], s[3 * 33]); o.z = pk2(s[4 * 33], s[5 * 33]); o.w = pk2(s[6 * 33], s[7 * 33]);
        *(u32x4*)(WT + (size_t)(prow0 + n) * K + k0 + 8 * c) = o; }
    LDS_WAIT(); asm volatile("" ::: "memory");
}
DI int win_srccol(int p) {
    const int pn = p >> 8, cc = p & 255, bj = cc >> 7, wc = (cc >> 5) & 3, j = cc & 31, hu = 4 * pn + wc, dim = 32 * bj + j;
    if (hu < 20) return hu * 64 + dim;
    if (hu < 28) return 1304 + (hu - 20) * 64 + dim;
    if (hu < 36) return 1816 + (hu - 28) * 64 + dim;
    if (hu == 36 && dim < 24) return 1280 + dim;
    return -1;
}
DI void p0_prologue(Frame& F) {
    LAS float* scr = (LAS float*)(F.lds + F.wave * 16384);
    const int gw = F.vcu * NWAVES + F.wave, NGW = F.G * NWAVES, lane = lane_id();
    unsigned char* ws = F.ws;
    constexpr int I_WIN = 16 * 80, I_WOUT = 16 * 32, I_CMP = 256, I_GU = 32 * 1024, I_DN = 32 * 512, NITEMS = I_WIN + I_WOUT + I_CMP + I_GU + I_DN;
    const float* ga = fin(F, 13); const float* gg = fin(F, 14); const float* g2 = fin(F, 16);
    const float* in0 = fin(F, 0); const float* in2 = fin(F, 2); const float* in5 = fin(F, 5); const float* in6 = fin(F, 6); const float* in7 = fin(F, 7); const float* in15 = fin(F, 15); const float* in19 = fin(F, 19); const float* in21 = fin(F, 21);
    for (int it = gw; it < NITEMS; it += NGW) {
        int r = it;
        if (r < I_GU) { const int e = r >> 10, q = r & 1023, kb = q >> 6, nb = q & 63;
            p0_item(in19 + (size_t)e * 1024 * 2048, 2048, (bf16*)(ws + WS_WGU) + (size_t)e * 2048 * 1024, 1024, 32 * nb, 64 * kb, [](int p) { return p; }, [g2](int k) { return g2[k]; }, scr, lane); continue; }
        r -= I_GU;
        if (r < I_DN) { const int e = r >> 9, q = r & 511, kb = q >> 5, nb = q & 31;
            p0_item(in21 + (size_t)e * 1024 * 1024, 1024, (bf16*)(ws + WS_WD) + (size_t)e * 1024 * 1024, 1024, 32 * nb, 64 * kb, [](int p) { return p; }, [](int) { return 1.0f; }, scr, lane); continue; }
        r -= I_DN;
        if (r < I_WIN) { const int kb = r / 80, nb = r % 80;
            p0_item(in2, 2328, (bf16*)(ws + WS_WIN), 1024, 32 * nb, 64 * kb, [](int p) { return win_srccol(p); }, [](int) { return 1.0f; }, scr, lane); continue; }
        r -= I_WIN;
        if (r < I_WOUT) { const int kb = r >> 5, nb = r & 31;
            p0_item(in15, 1024, (bf16*)(ws + WS_WOUT), 1024, 32 * nb, 64 * kb, [](int p) { return p; }, [ga, gg](int k) { return k < 512 ? ga[k] : gg[k - 512]; }, scr, lane); continue; }
        r -= I_WOUT;
        { const int ti = r >> 7, half = (r >> 6) & 1, kb = (r >> 2) & 15, nb = r & 3;
            p0_item(in6 + (size_t)ti * 2048 * 128 + (size_t)half * 1024 * 128, 128, (bf16*)(ws + WS_WCMP) + (size_t)ti * 256 * 1024, 1024, half * 128 + 32 * nb, 64 * kb, [half](int p) { return p - half * 128; }, [](int) { return 1.0f; }, scr, lane); }
    }
    const float* g1 = fin(F, 1);
    f32x4 gv[4];
#pragma unroll
    for (int j = 0; j < 4; ++j) gv[j] = *(const f32x4*)(g1 + 4 * lane + 256 * j);
    for (int m = gw; m < M; m += NGW) {
        const f32x4* xr = (const f32x4*)(in0 + (size_t)m * D) + lane;
        f32x4 v[4]; float s = 0.f;
#pragma unroll
        for (int j = 0; j < 4; ++j) { v[j] = xr[64 * j]; s += (v[j].x * v[j].x + v[j].y * v[j].y) + (v[j].z * v[j].z + v[j].w * v[j].w); }
        const float rinv = __builtin_amdgcn_rsqf(wave_sum(s) * (1.f / D) + EPS);
        u32x2* o8 = (u32x2*)((bf16*)(ws + WS_XN) + (size_t)m * D) + lane;
#pragma unroll
        for (int j = 0; j < 4; ++j) { const f32x4 y = v[j] * rinv * gv[j]; u32x2 w; w.x = pk2(y.x, y.y); w.y = pk2(y.z, y.w); o8[64 * j] = w; }
    }
    for (int it = gw; it < 256; it += NGW) {
        const int ti = it >> 7, n = it & 127; const float* pos = in5 + ti * 2048; const float* w1 = in6 + (size_t)ti * 2048 * 128 + n;
        float s = 0.f;
        for (int i = 0; i < 32; ++i) { const int k = lane + 64 * i; s += pos[k] * w1[(size_t)k * 128]; }
        s = wave_sum(s);
        if (lane == 0) ((float*)(ws + WS_C1))[it] = s + in7[it];
    }
}

#define MFMA32(a, b, c) __builtin_amdgcn_mfma_f32_32x32x16_bf16((a), (b), (c), 0, 0, 0)
typedef short v4i16_t __attribute__((ext_vector_type(4)));
DI s16x4 vtr(LAS const char* p) { return __builtin_bit_cast(s16x4, __builtin_amdgcn_ds_read_tr16_b64_v4i16((LAS v4i16_t*)p)); }
DI bf16x8 mk8(s16x4 lo, s16x4 hi) { return (bf16x8){lo[0], lo[1], lo[2], lo[3], hi[0], hi[1], hi[2], hi[3]}; }

DI void gmlp_phase(Frame& F) {
    const int c = F.vcu, g = F.wave, lane = lane_id(), col = lane & 31, hi = lane >> 5;
    const bool act = c < 128;
    const size_t row0 = (size_t)c * 128;
    LAS char* vl = (LAS char*)F.lds + g * 16384;
    LAS float* ssqL = (LAS float*)(F.lds + RING_BYTES);
    unsigned opk[4][2][8];
    if (act) {
        const bf16* VG = (const bf16*)(F.ws + WS_VG); const float* vssq = (const float*)(F.ws + WS_VSSQ); const float* vgain = fin(F, 10);
        const bf16* U = (const bf16*)(F.ws + WS_U);
#pragma unroll 4
        for (int i = 0; i < 16; ++i) { const int id = i * 64 + lane, s = id >> 3, ch = id & 7;
            const u32x4 raw = *(const u32x4*)(VG + (row0 + s) * 512 + g * 64 + ch * 8);
            const float rinv = __builtin_amdgcn_rsqf(vssq[row0 + s] * (1.0f / 512.0f) + EPS);
            const f32x4 ga = *(const f32x4*)(vgain + g * 64 + ch * 8), gb = *(const f32x4*)(vgain + g * 64 + ch * 8 + 4);
            u32x4 w; w.x = pk2(bflo(raw.x) * rinv * ga.x, bfhi(raw.x) * rinv * ga.y); w.y = pk2(bflo(raw.y) * rinv * ga.z, bfhi(raw.y) * rinv * ga.w);
            w.z = pk2(bflo(raw.z) * rinv * gb.x, bfhi(raw.z) * rinv * gb.y); w.w = pk2(bflo(raw.w) * rinv * gb.z, bfhi(raw.w) * rinv * gb.w);
            *(LAS u32x4*)(vl + (ch >> 2) * 8192 + s * 64 + (ch & 3) * 16) = w; }
        LAS const char* vp = vl + ((lane >> 4) & 1) * 32 + (lane & 3) * 8 + (4 * hi + ((lane & 15) >> 2)) * 64;
        const float* wsg = fin(F, 11) + (size_t)g * 128 * 128; const float* bs = fin(F, 12) + g * 128;
#pragma unroll
        for (int tb = 0; tb < 4; ++tb) {
            const int t = 32 * tb + col;
            f32x16 a0 = {}, a1 = {};
#pragma unroll
            for (int ks = 0; ks < 2 * (tb + 1); ++ks) {
                const int s0 = 16 * ks + 4 * hi;
                f32x4 wa = *(const f32x4*)(wsg + t * 128 + s0), wb = *(const f32x4*)(wsg + t * 128 + s0 + 8);
#pragma unroll
                for (int i = 0; i < 4; ++i) { wa[i] = (s0 + i <= t) ? wa[i] : 0.f; wb[i] = (s0 + 8 + i <= t) ? wb[i] : 0.f; }
                u32x4 wp; wp.x = pk2(wa[0], wa[1]); wp.y = pk2(wa[2], wa[3]); wp.z = pk2(wb[0], wb[1]); wp.w = pk2(wb[2], wb[3]);
                const bf16x8 wf = __builtin_bit_cast(bf16x8, wp);
                const bf16x8 v0 = mk8(vtr(vp + ks * 1024), vtr(vp + ks * 1024 + 512));
                const bf16x8 v1 = mk8(vtr(vp + 8192 + ks * 1024), vtr(vp + 8192 + ks * 1024 + 512));
                a0 = MFMA32(v0, wf, a0); a1 = MFMA32(v1, wf, a1);
            }
            const float bt = bs[t]; const size_t row = row0 + t; float ssq = 0.f;
#pragma unroll
            for (int db = 0; db < 2; ++db)
#pragma unroll
                for (int a = 0; a < 4; ++a) { const int d0 = 32 * db + 8 * a + 4 * hi;
                    const u32x2 uu = *(const u32x2*)(U + row * 512 + g * 64 + d0);
                    const float o0 = bflo(uu.x) * ((db ? a1[4 * a] : a0[4 * a]) + bt), o1 = bfhi(uu.x) * ((db ? a1[4 * a + 1] : a0[4 * a + 1]) + bt);
                    const float o2 = bflo(uu.y) * ((db ? a1[4 * a + 2] : a0[4 * a + 2]) + bt), o3 = bfhi(uu.y) * ((db ? a1[4 * a + 3] : a0[4 * a + 3]) + bt);
                    ssq += (o0 * o0 + o1 * o1) + (o2 * o2 + o3 * o3);
                    opk[tb][db][2 * a] = pk2(o0, o1); opk[tb][db][2 * a + 1] = pk2(o2, o3); }
            ssq += __shfl_xor(ssq, 32);
            if (hi == 0) ssqL[g * 128 + t] = ssq;
        }
    }
    __syncthreads();
    if (act) {
        bf16* MX = (bf16*)(F.ws + WS_MIXED);
#pragma unroll
        for (int tb = 0; tb < 4; ++tb) {
            const int t = 32 * tb + col; float tot = 0.f;
#pragma unroll
            for (int gg = 0; gg < 8; ++gg) tot += ssqL[gg * 128 + t];
            const float rinv = __builtin_amdgcn_rsqf(tot * (1.0f / 512.0f) + EPS);
#pragma unroll
            for (int db = 0; db < 2; ++db)
#pragma unroll
                for (int a = 0; a < 4; ++a) { const int d0 = 32 * db + 8 * a + 4 * hi; const unsigned w0 = opk[tb][db][2 * a], w1 = opk[tb][db][2 * a + 1];
                    u32x2 w; w.x = pk2(bflo(w0) * rinv, bfhi(w0) * rinv); w.y = pk2(bflo(w1) * rinv, bfhi(w1) * rinv);
                    *(u32x2*)(MX + (row0 + t) * 1024 + 512 + g * 64 + d0) = w; }
        }
    }
    __syncthreads();
}

DI void cmp2_phase(Frame& F) {
    const int gw = F.vcu * NWAVES + F.wave, NGW = F.G * NWAVES, lane = lane_id();
    const float* TC = (const float*)(F.ws + WS_TCMP); const float* c1 = (const float*)(F.ws + WS_C1);
    const float* in4 = fin(F, 4); const float* in8 = fin(F, 8); const float* in9 = fin(F, 9);
    for (int id = gw; id < 4096; id += NGW) {
        const int ti = id >> 11, seg = id & 2047, c = seg & 511;
        bf16* dst = (bf16*)(F.ws + (ti ? WS_VCC : WS_KCN)) + (size_t)seg * 64;
        if (c == 511) { dst[lane] = 0; continue; }
        const float* Tt = TC + (size_t)ti * 2048 * 256;
        const float h0 = gelu_tanh(Tt[(size_t)seg * 256 + lane] + Tt[(size_t)(seg + 1) * 256 + 128 + lane] + c1[ti * 128 + lane]);
        const float h1 = gelu_tanh(Tt[(size_t)seg * 256 + 64 + lane] + Tt[(size_t)(seg + 1) * 256 + 192 + lane] + c1[ti * 128 + 64 + lane]);
        const float* w2 = in8 + (size_t)ti * 128 * 64;
        float o = in9[ti * 64 + lane];
#pragma unroll
        for (int k = 0; k < 64; ++k) o += __int_as_float(__builtin_amdgcn_readlane(__float_as_int(h0), k)) * w2[k * 64 + lane];
#pragma unroll
        for (int k = 0; k < 64; ++k) o += __int_as_float(__builtin_amdgcn_readlane(__float_as_int(h1), k)) * w2[(64 + k) * 64 + lane];
        if (ti == 0) { const float ss = wave_sum(o * o); o = o * __builtin_amdgcn_rsqf(ss * (1.0f / 64.0f) + EPS) * in4[lane]; }
        dst[lane] = (bf16)(pk2(o, 0.f) & 0xffffu);
    }
}

struct AttnP { const bf16 *Q, *KCN, *VCC, *KS, *VS, *KW, *VW; const float* GATES; bf16* MX; };
DI void qk_tile(const bf16* Kt, const bf16x8 (&qf)[4], f32x16& p0, f32x16& p1, int col, int hi) {
    const char* kp = (const char*)Kt + (unsigned)(col * 128 + 16 * hi);
    bf16x8 k0[4], k1[4];
#pragma unroll
    for (int d0 = 0; d0 < 4; ++d0) { k0[d0] = *(const bf16x8*)(kp + 32 * d0); k1[d0] = *(const bf16x8*)(kp + 4096 + 32 * d0); }
    p0 = (f32x16){}; p1 = (f32x16){};
#pragma unroll
    for (int d0 = 0; d0 < 4; ++d0) { p0 = MFMA32(k0[d0], qf[d0], p0); p1 = MFMA32(k1[d0], qf[d0], p1); }
}
DI void v_stage(const bf16* Vt, LAS char* vl, int lane) {
    const char* vb = (const char*)Vt + (unsigned)lane * 16u;
    LAS char* dl = vl + ((lane & 7) >> 2) * 4096 + (lane >> 3) * 64 + (lane & 3) * 16;
#pragma unroll
    for (int hf = 0; hf < 2; ++hf) {
        u32x4 tmp[4];
#pragma unroll
        for (int i = 0; i < 4; ++i) tmp[i] = *(const u32x4*)(vb + (hf * 4 + i) * 1024);
#pragma unroll
        for (int i = 0; i < 4; ++i) *(LAS u32x4*)(dl + (hf * 4 + i) * 512) = tmp[i];
        __builtin_amdgcn_sched_barrier(0);
    }
}
DI void pv_tile(LAS const char* vp, const u32x4 (&pw)[4], f32x16& o0, f32x16& o1) {
#pragma unroll
    for (int ks = 0; ks < 4; ++ks) {
        const bf16x8 v0 = mk8(vtr(vp + ks * 1024), vtr(vp + ks * 1024 + 512));
        const bf16x8 v1 = mk8(vtr(vp + 4096 + ks * 1024), vtr(vp + 4096 + ks * 1024 + 512));
        const bf16x8 pf = __builtin_bit_cast(bf16x8, pw[ks]);
        o0 = MFMA32(v0, pf, o0); o1 = MFMA32(v1, pf, o1);
    }
}
template <bool WIN, int KS> DI void bias_mask(f32x16& p, float A, float B, int dbase) {
#pragma unroll
    for (int r = 0; r < 16; ++r) { const int cr = (r & 3) + 8 * (r >> 2);
        const float s = p[r] + __builtin_fmaf(B, (float)cr, A);
        bool ok = dbase >= KS * cr; if (WIN) ok = ok && (dbase - KS * cr < 512);
        p[r] = ok ? s : -INFINITY; }
}
DI float tile_max(const f32x16& p0, const f32x16& p1) {
    float a = fmaxf(p0[0], p1[0]);
#pragma unroll
    for (int r = 1; r < 16; ++r) a = fmaxf(a, fmaxf(p0[r], p1[r]));
    return fmaxf(a, __shfl_xor(a, 32));
}
DI void pack_p(const f32x16& p0, const f32x16& p1, u32x4 (&pw)[4]) {
#pragma unroll
    for (int s = 0; s < 2; ++s) {
        pw[s] = (u32x4){pk2(p0[8 * s], p0[8 * s + 1]), pk2(p0[8 * s + 2], p0[8 * s + 3]), pk2(p0[8 * s + 4], p0[8 * s + 5]), pk2(p0[8 * s + 6], p0[8 * s + 7])};
        pw[2 + s] = (u32x4){pk2(p1[8 * s], p1[8 * s + 1]), pk2(p1[8 * s + 2], p1[8 * s + 3]), pk2(p1[8 * s + 4], p1[8 * s + 5]), pk2(p1[8 * s + 6], p1[8 * s + 7])};
    }
}
template <bool WIN> DI void online_tile(const bf16* Kt, const bf16* Vt, int P0, bool selb, int t, float sl2, const bf16x8 (&qf)[4], LAS char* vl, LAS const char* vp,
                                        float& m, float& l, f32x16& o0, f32x16& o1, int lane, int col, int hi) {
    f32x16 p0, p1;
    qk_tile(Kt, qf, p0, p1, col, hi);
    v_stage(Vt, vl, lane);
    const int db0 = t - P0 - 4 * hi, db1 = db0 - 32;
    const float ninf = selb ? 0.f : -INFINITY;
    bias_mask<WIN, 1>(p0, -sl2 * (float)db0 + ninf, sl2, db0);
    bias_mask<WIN, 1>(p1, -sl2 * (float)db1 + ninf, sl2, db1);
    const float mt = tile_max(p0, p1);
    const float mn = fmaxf(m, mt), alpha = __builtin_amdgcn_exp2f(m - mn);
    m = mn;
    float rs = 0.f;
#pragma unroll
    for (int r = 0; r < 16; ++r) { p0[r] = __builtin_amdgcn_exp2f(p0[r] - mn); p1[r] = __builtin_amdgcn_exp2f(p1[r] - mn); rs += p0[r] + p1[r]; }
    rs += __shfl_xor(rs, 32);
    l = l * alpha + rs;
#pragma unroll
    for (int r = 0; r < 16; ++r) { o0[r] *= alpha; o1[r] *= alpha; }
    u32x4 pw[4]; pack_p(p0, p1, pw);
    pv_tile(vp, pw, o0, o1);
}
DI void attn_group(const AttnP& P, const int g, const int b, const int t0, const int lane, LAS char* wl, f32x16& ot0, f32x16& ot1) {
    const int col = lane & 31, hi = lane >> 5, hh = col >> 3, tok = col & 7, t = t0 + tok, h = 4 * g + hh;
    const size_t row = (size_t)b * T + t;
    const float sl2 = __builtin_amdgcn_exp2f(-(float)(h + 1)) * LOG2E;
    bf16x8 qf[4];
#pragma unroll
    for (int d0 = 0; d0 < 4; ++d0) qf[d0] = *(const bf16x8*)(P.Q + row * 512 + h * 64 + 16 * d0 + 8 * hi);
    const float gt0 = P.GATES[row * 24 + h * 3], gt1 = P.GATES[row * 24 + h * 3 + 1], gt2 = P.GATES[row * 24 + h * 3 + 2];
    const size_t hb = (size_t)(b * 2 + g);
    const bf16* Kc = P.KCN + hb * 512 * 64; const bf16* Vc = P.VCC + hb * 512 * 64;
    const bf16* Ks = P.KS + hb * T * 64; const bf16* Vs = P.VS + hb * T * 64; const bf16* Kw = P.KW + hb * T * 64; const bf16* Vw = P.VW + hb * T * 64;
    LAS char* vl = wl; LAS float* imp = (LAS float*)(wl + 8192);
    LAS const char* vp = vl + ((lane >> 4) & 1) * 32 + (lane & 3) * 8 + (4 * hi + ((lane & 15) >> 2)) * 64;
#pragma unroll
    for (int i = 0; i < 4; ++i) ((LAS u32x4*)(wl + 8192))[i * 64 + lane] = (u32x4){0u, 0u, 0u, 0u};
    const int tmax = t0 + 7, ncv = tmax >= 31 ? ((tmax - 31) >> 4) + 1 : 0, ntc = (ncv + 63) >> 6;
    float m = -1e30f, l = 0.f;
    for (int tile = 0; tile < ntc; ++tile) {
        f32x16 p0, p1; qk_tile(Kc + tile * 4096, qf, p0, p1, col, hi);
        const int db0 = t - 31 - 16 * (64 * tile + 4 * hi), db1 = db0 - 512;
        bias_mask<false, 16>(p0, -sl2 * (float)db0, sl2 * 16.f, db0); bias_mask<false, 16>(p1, -sl2 * (float)db1, sl2 * 16.f, db1);
        const float mt = tile_max(p0, p1), mn = fmaxf(m, mt);
        float rs = 0.f;
#pragma unroll
        for (int r = 0; r < 16; ++r) rs += __builtin_amdgcn_exp2f(p0[r] - mn) + __builtin_amdgcn_exp2f(p1[r] - mn);
        rs += __shfl_xor(rs, 32);
        l = l * __builtin_amdgcn_exp2f(m - mn) + rs; m = mn;
    }
    const float il = l > 0.f ? 1.0f / l : 0.f;
    f32x16 oc0 = {}, oc1 = {};
    for (int tile = 0; tile < ntc; ++tile) {
        f32x16 p0, p1; qk_tile(Kc + tile * 4096, qf, p0, p1, col, hi);
        v_stage(Vc + tile * 4096, vl, lane);
        const int db0 = t - 31 - 16 * (64 * tile + 4 * hi), db1 = db0 - 512;
        bias_mask<false, 16>(p0, -sl2 * (float)db0, sl2 * 16.f, db0); bias_mask<false, 16>(p1, -sl2 * (float)db1, sl2 * 16.f, db1);
#pragma unroll
        for (int r = 0; r < 16; ++r) { p0[r] = __builtin_amdgcn_exp2f(p0[r] - m) * il; p1[r] = __builtin_amdgcn_exp2f(p1[r] - m) * il; }
#pragma unroll
        for (int kb = 0; kb < 2; ++kb)
#pragma unroll
            for (int a = 0; a < 4; ++a) { const int r0 = 4 * a;
                const float x0 = kb ? p1[r0] : p0[r0], x1 = kb ? p1[r0 + 1] : p0[r0 + 1], x2 = kb ? p1[r0 + 2] : p0[r0 + 2], x3 = kb ? p1[r0 + 3] : p0[r0 + 3];
                float mv = (x0 + x1) + (x2 + 0.5f * x3), sv = 0.5f * x3;
                mv += __shfl_xor(mv, 8); mv += __shfl_xor(mv, 16); sv += __shfl_xor(sv, 8); sv += __shfl_xor(sv, 16);
                const int n = 16 * tile + 8 * kb + 2 * a + hi;
                if (hh == 0) { __hip_atomic_fetch_add(&imp[tok * 128 + n], mv, __ATOMIC_RELAXED, __HIP_MEMORY_SCOPE_WORKGROUP);
                    if (n < 127) __hip_atomic_fetch_add(&imp[tok * 128 + n + 1], sv, __ATOMIC_RELAXED, __HIP_MEMORY_SCOPE_WORKGROUP); } }
        u32x4 pw[4]; pack_p(p0, p1, pw);
        pv_tile(vp, pw, oc0, oc1);
    }
    unsigned mwl[4], uw[4];
    if (t0 + 7 < 1024) {
        const int nb = t >> 6; mwl[0] = (2u << nb) - 1u; mwl[1] = 0u; mwl[2] = 0u; mwl[3] = 0u;
        uw[0] = (2u << ((t0 + 7) >> 6)) - 1u; uw[1] = 0u; uw[2] = 0u; uw[3] = 0u;
    } else {
        const int tk = lane >> 3, sub = lane & 7, nbk = (t0 + tk) >> 6;
        unsigned keys[16];
#pragma unroll
        for (int i = 0; i < 16; ++i) { const int n = i * 8 + sub; const float v = imp[tk * 128 + n];
            keys[i] = (n < nbk && n != 0) ? ((__float_as_uint(v) & ~255u) | (unsigned)(255 - n)) : 0u; }
        unsigned mw[4] = {1u, 0u, 0u, 0u};
#pragma unroll
        for (int w = 0; w < 4; ++w) mw[w] |= ((nbk >> 5) == w) ? (1u << (nbk & 31)) : 0u;
        for (int round = 0; round < 14; ++round) {
            unsigned mx = keys[0];
#pragma unroll
            for (int i = 1; i < 16; ++i) mx = mx > keys[i] ? mx : keys[i];
            unsigned o;
            o = __shfl_xor(mx, 1); mx = mx > o ? mx : o; o = __shfl_xor(mx, 2); mx = mx > o ? mx : o; o = __shfl_xor(mx, 4); mx = mx > o ? mx : o;
            if (mx != 0u) { const int n = 255 - (int)(mx & 255u);
#pragma unroll
                for (int w = 0; w < 4; ++w) mw[w] |= ((n >> 5) == w) ? (1u << (n & 31)) : 0u;
#pragma unroll
                for (int i = 0; i < 16; ++i) keys[i] = keys[i] == mx ? 0u : keys[i]; }
        }
#pragma unroll
        for (int w = 0; w < 4; ++w) { mwl[w] = __shfl(mw[w], (lane & 7) * 8);
            unsigned u = mw[w]; u |= __shfl_xor(u, 8); u |= __shfl_xor(u, 16); u |= __shfl_xor(u, 32); uw[w] = __builtin_amdgcn_readfirstlane(u); }
    }
    LAS u32x4* acs = (LAS u32x4*)(wl + 8192 + lane * 64);
#pragma unroll
    for (int a = 0; a < 2; ++a) {
        acs[a] = (u32x4){pk2(oc0[8 * a] * gt0, oc0[8 * a + 1] * gt0), pk2(oc0[8 * a + 2] * gt0, oc0[8 * a + 3] * gt0), pk2(oc0[8 * a + 4] * gt0, oc0[8 * a + 5] * gt0), pk2(oc0[8 * a + 6] * gt0, oc0[8 * a + 7] * gt0)};
        acs[2 + a] = (u32x4){pk2(oc1[8 * a] * gt0, oc1[8 * a + 1] * gt0), pk2(oc1[8 * a + 2] * gt0, oc1[8 * a + 3] * gt0), pk2(oc1[8 * a + 4] * gt0, oc1[8 * a + 5] * gt0), pk2(oc1[8 * a + 6] * gt0, oc1[8 * a + 7] * gt0)};
    }
    {
        float ms = -1e30f, ls = 0.f; f32x16 o0 = {}, o1 = {};
        const int nlast = (t0 + 7) >> 6;
        for (int n = 0; n <= nlast; ++n) {
            const unsigned uword = (n < 32) ? uw[0] : (n < 64) ? uw[1] : (n < 96) ? uw[2] : uw[3];
            if (!((uword >> (n & 31)) & 1u)) continue;
            const unsigned lword = (n < 32) ? mwl[0] : (n < 64) ? mwl[1] : (n < 96) ? mwl[2] : mwl[3];
            const bool selb = (lword >> (n & 31)) & 1u;
            online_tile<false>(Ks + (size_t)n * 4096, Vs + (size_t)n * 4096, 64 * n, selb, t, sl2, qf, vl, vp, ms, ls, o0, o1, lane, col, hi);
        }
        const float sc = gt1 / ls;
#pragma unroll
        for (int a = 0; a < 2; ++a) {
            const u32x4 q0 = acs[a], q1 = acs[2 + a];
            acs[a] = (u32x4){pk2(bflo(q0.x) + o0[8 * a] * sc, bfhi(q0.x) + o0[8 * a + 1] * sc), pk2(bflo(q0.y) + o0[8 * a + 2] * sc, bfhi(q0.y) + o0[8 * a + 3] * sc),
                             pk2(bflo(q0.z) + o0[8 * a + 4] * sc, bfhi(q0.z) + o0[8 * a + 5] * sc), pk2(bflo(q0.w) + o0[8 * a + 6] * sc, bfhi(q0.w) + o0[8 * a + 7] * sc)};
            acs[2 + a] = (u32x4){pk2(bflo(q1.x) + o1[8 * a] * sc, bfhi(q1.x) + o1[8 * a + 1] * sc), pk2(bflo(q1.y) + o1[8 * a + 2] * sc, bfhi(q1.y) + o1[8 * a + 3] * sc),
                                 pk2(bflo(q1.z) + o1[8 * a + 4] * sc, bfhi(q1.z) + o1[8 * a + 5] * sc), pk2(bflo(q1.w) + o1[8 * a + 6] * sc, bfhi(q1.w) + o1[8 * a + 7] * sc)};
        }
    }
    {
        float mw_ = -1e30f, lw = 0.f; f32x16 o0 = {}, o1 = {};
        const int nfirst = t0 >= 511 ? (t0 - 511) >> 6 : 0, nlast = (t0 + 7) >> 6;
        for (int n = nfirst; n <= nlast; ++n)
            online_tile<true>(Kw + (size_t)n * 4096, Vw + (size_t)n * 4096, 64 * n, true, t, sl2, qf, vl, vp, mw_, lw, o0, o1, lane, col, hi);
        const float sc = gt2 / lw;
#pragma unroll
        for (int a = 0; a < 2; ++a) {
            const u32x4 q0 = acs[a], q1 = acs[2 + a];
            ot0[8 * a] = bflo(q0.x) + o0[8 * a] * sc; ot0[8 * a + 1] = bfhi(q0.x) + o0[8 * a + 1] * sc; ot0[8 * a + 2] = bflo(q0.y) + o0[8 * a + 2] * sc; ot0[8 * a + 3] = bfhi(q0.y) + o0[8 * a + 3] * sc;
            ot0[8 * a + 4] = bflo(q0.z) + o0[8 * a + 4] * sc; ot0[8 * a + 5] = bfhi(q0.z) + o0[8 * a + 5] * sc; ot0[8 * a + 6] = bflo(q0.w) + o0[8 * a + 6] * sc; ot0[8 * a + 7] = bfhi(q0.w) + o0[8 * a + 7] * sc;
            ot1[8 * a] = bflo(q1.x) + o1[8 * a] * sc; ot1[8 * a + 1] = bfhi(q1.x) + o1[8 * a + 1] * sc; ot1[8 * a + 2] = bflo(q1.y) + o1[8 * a + 2] * sc; ot1[8 * a + 3] = bfhi(q1.y) + o1[8 * a + 3] * sc;
            ot1[8 * a + 4] = bflo(q1.z) + o1[8 * a + 4] * sc; ot1[8 * a + 5] = bfhi(q1.z) + o1[8 * a + 5] * sc; ot1[8 * a + 6] = bflo(q1.w) + o1[8 * a + 6] * sc; ot1[8 * a + 7] = bfhi(q1.w) + o1[8 * a + 7] * sc;
        }
    }
}
DI void attn_phase(Frame& F) {
    AttnP P; P.Q = (const bf16*)(F.ws + WS_Q); P.KCN = (const bf16*)(F.ws + WS_KCN); P.VCC = (const bf16*)(F.ws + WS_VCC);
    P.KS = (const bf16*)(F.ws + WS_KS); P.VS = (const bf16*)(F.ws + WS_VS); P.KW = (const bf16*)(F.ws + WS_KW); P.VW = (const bf16*)(F.ws + WS_VW);
    P.GATES = (const float*)(F.ws + WS_GATES); P.MX = (bf16*)(F.ws + WS_MIXED);
    const int gw = F.vcu * NWAVES + F.wave, NGW = F.G * NWAVES, lane = lane_id();
    LAS char* wl = (LAS char*)F.lds + F.wave * 16384;
    for (int u = gw; u < M / 8; u += NGW) {
        const int b = u >> 10, t0 = (u & 1023) * 8;
        const int col = lane & 31, hi = lane >> 5, hh = col >> 3, tok = col & 7;
        LAS u32x4* st = (LAS u32x4*)(wl + 12288 + lane * 64);
        float ssq = 0.f;
        {
            f32x16 oa0, oa1;
            attn_group(P, 0, b, t0, lane, wl, oa0, oa1);
#pragma unroll
            for (int r = 0; r < 16; ++r) ssq += oa0[r] * oa0[r] + oa1[r] * oa1[r];
#pragma unroll
            for (int a = 0; a < 2; ++a) {
                st[a] = (u32x4){pk2(oa0[8 * a], oa0[8 * a + 1]), pk2(oa0[8 * a + 2], oa0[8 * a + 3]), pk2(oa0[8 * a + 4], oa0[8 * a + 5]), pk2(oa0[8 * a + 6], oa0[8 * a + 7])};
                st[2 + a] = (u32x4){pk2(oa1[8 * a], oa1[8 * a + 1]), pk2(oa1[8 * a + 2], oa1[8 * a + 3]), pk2(oa1[8 * a + 4], oa1[8 * a + 5]), pk2(oa1[8 * a + 6], oa1[8 * a + 7])};
            }
        }
        f32x16 ob0, ob1;
        attn_group(P, 1, b, t0, lane, wl, ob0, ob1);
#pragma unroll
        for (int r = 0; r < 16; ++r) ssq += ob0[r] * ob0[r] + ob1[r] * ob1[r];
        ssq += __shfl_xor(ssq, 32); ssq += __shfl_xor(ssq, 8); ssq += __shfl_xor(ssq, 16);
        const float rinv = __builtin_amdgcn_rsqf(ssq * (1.0f / 512.0f) + EPS);
        bf16* mp = P.MX + ((size_t)b * T + t0 + tok) * 1024 + hh * 64 + 4 * hi;
#pragma unroll
        for (int a = 0; a < 2; ++a) {
            const u32x4 q0 = st[a], q1 = st[2 + a];
            u32x2 w;
            w.x = pk2(bflo(q0.x) * rinv, bfhi(q0.x) * rinv); w.y = pk2(bflo(q0.y) * rinv, bfhi(q0.y) * rinv); *(u32x2*)(mp + 8 * (2 * a)) = w;
            w.x = pk2(bflo(q0.z) * rinv, bfhi(q0.z) * rinv); w.y = pk2(bflo(q0.w) * rinv, bfhi(q0.w) * rinv); *(u32x2*)(mp + 8 * (2 * a + 1)) = w;
            w.x = pk2(bflo(q1.x) * rinv, bfhi(q1.x) * rinv); w.y = pk2(bflo(q1.y) * rinv, bfhi(q1.y) * rinv); *(u32x2*)(mp + 32 + 8 * (2 * a)) = w;
            w.x = pk2(bflo(q1.z) * rinv, bfhi(q1.z) * rinv); w.y = pk2(bflo(q1.w) * rinv, bfhi(q1.w) * rinv); *(u32x2*)(mp + 32 + 8 * (2 * a + 1)) = w;
        }
#pragma unroll
        for (int a = 0; a < 4; ++a) {
            u32x2 w;
            w.x = pk2(ob0[4 * a] * rinv, ob0[4 * a + 1] * rinv); w.y = pk2(ob0[4 * a + 2] * rinv, ob0[4 * a + 3] * rinv); *(u32x2*)(mp + 256 + 8 * a) = w;
            w.x = pk2(ob1[4 * a] * rinv, ob1[4 * a + 1] * rinv); w.y = pk2(ob1[4 * a + 2] * rinv, ob1[4 * a + 3] * rinv); *(u32x2*)(mp + 256 + 32 + 8 * a) = w;
        }
    }
}

DI void route_phase(Frame& F) {
    LAS float* wl = (LAS float*)F.lds;
    LAS int* hist = (LAS int*)(F.lds + AUX_OFF); LAS int* base = hist + 32; LAS int* tmp = hist + 64; LAS float* tmpg = (LAS float*)(hist + 64 + 256); LAS float* tmpr = (LAS float*)(hist + 64 + 512);
    const float* wr = fin(F, 17);
    const int lane = lane_id(), tid = F.wave * 64 + lane;
    for (int i = tid; i < 1024 * 8; i += NWAVES * 64) { const int k = i >> 3, q = i & 7; *(LAS f32x4*)(wl + k * 36 + q * 4) = *(const f32x4*)(wr + k * 32 + q * 4); }
    const float* g2 = fin(F, 16);
    float g2v[16];
#pragma unroll
    for (int i = 0; i < 16; ++i) g2v[i] = g2[lane + 64 * i];
    const int e = lane >> 1; const float be = fin(F, 18)[e];
    int* list = (int*)(F.ws + WS_LIST); int* tokinfo = (int*)(F.ws + WS_TOKINFO); float* tgate = (float*)(F.ws + WS_TGATE);
    for (int blk = F.vcu; blk < M / 64; blk += F.G) {
        if (tid < 32) hist[tid] = 0;
        __syncthreads();
        for (int rr = 0; rr < 8; ++rr) {
            const int tok = blk * 64 + F.wave * 8 + rr;
            const float* xr = F.out + (size_t)tok * D;
            float xv[16]; float ssq = 0.f;
#pragma unroll
            for (int i = 0; i < 16; ++i) { xv[i] = xr[lane + 64 * i]; ssq += xv[i] * xv[i]; }
            const float rinv = __builtin_amdgcn_rsqf(wave_sum(ssq) * (1.f / D) + EPS);
            float acc[32];
#pragma unroll
            for (int j = 0; j < 32; ++j) acc[j] = 0.f;
#pragma unroll
            for (int i = 0; i < 16; ++i) { const float xn = xv[i] * rinv * g2v[i]; const LAS float* wrow = wl + (lane + 64 * i) * 36;
#pragma unroll
                for (int q = 0; q < 8; ++q) { const f32x4 w = *(const LAS f32x4*)(wrow + 4 * q); acc[4 * q] += xn * w.x; acc[4 * q + 1] += xn * w.y; acc[4 * q + 2] += xn * w.z; acc[4 * q + 3] += xn * w.w; } }
            float v16[16], v8[8], v4[4], v2[2];
            { const bool bb = lane & 32;
#pragma unroll
              for (int i = 0; i < 16; ++i) { const float mine = bb ? acc[16 + i] : acc[i], oth = bb ? acc[i] : acc[16 + i]; v16[i] = mine + __shfl_xor(oth, 32); } }
            { const bool bb = lane & 16;
#pragma unroll
              for (int i = 0; i < 8; ++i) { const float mine = bb ? v16[8 + i] : v16[i], oth = bb ? v16[i] : v16[8 + i]; v8[i] = mine + __shfl_xor(oth, 16); } }
            { const bool bb = lane & 8;
#pragma unroll
              for (int i = 0; i < 4; ++i) { const float mine = bb ? v8[4 + i] : v8[i], oth = bb ? v8[i] : v8[4 + i]; v4[i] = mine + __shfl_xor(oth, 8); } }
            { const bool bb = lane & 4;
#pragma unroll
              for (int i = 0; i < 2; ++i) { const float mine = bb ? v4[2 + i] : v4[i], oth = bb ? v4[i] : v4[2 + i]; v2[i] = mine + __shfl_xor(oth, 4); } }
            float lg; { const bool bb = lane & 2; const float mine = bb ? v2[1] : v2[0], oth = bb ? v2[0] : v2[1]; lg = mine + __shfl_xor(oth, 2); }
            lg += __shfl_xor(lg, 1);
            lg += be;
            unsigned ub = __float_as_uint(lg); ub = (ub & 0x80000000u) ? ~ub : (ub | 0x80000000u);
            unsigned key = (ub & ~31u) | (unsigned)(31 - e);
            int ek[4]; float vk[4];
#pragma unroll
            for (int k = 0; k < 4; ++k) {
                unsigned mx = key, o;
                o = __shfl_xor(mx, 2); mx = mx > o ? mx : o; o = __shfl_xor(mx, 4); mx = mx > o ? mx : o; o = __shfl_xor(mx, 8); mx = mx > o ? mx : o;
                o = __shfl_xor(mx, 16); mx = mx > o ? mx : o; o = __shfl_xor(mx, 32); mx = mx > o ? mx : o;
                ek[k] = 31 - (int)(mx & 31u); vk[k] = __shfl(lg, 2 * ek[k]);
                if (e == ek[k]) key = 0u;
            }
            const float e1 = __expf(vk[1] - vk[0]), e2 = __expf(vk[2] - vk[0]), e3 = __expf(vk[3] - vk[0]);
            const float inv = 1.0f / (1.0f + e1 + e2 + e3);
            if (lane < 4) {
                const int ee = lane == 0 ? ek[0] : lane == 1 ? ek[1] : lane == 2 ? ek[2] : ek[3];
                const float gg = (lane == 0 ? 1.0f : lane == 1 ? e1 : lane == 2 ? e2 : e3) * inv;
                const int rank = __hip_atomic_fetch_add(&hist[ee], 1, __ATOMIC_RELAXED, __HIP_MEMORY_SCOPE_WORKGROUP);
                const int slot = (F.wave * 8 + rr) * 4 + lane;
                tmp[slot] = (ee << 16) | rank; tmpg[slot] = gg;
                if (lane == 0) tmpr[F.wave * 8 + rr] = rinv;
            }
        }
        __syncthreads();
        if (tid < 32) base[tid] = (int)__hip_atomic_fetch_add((unsigned*)(F.ctl + CW_CNT + tid), (unsigned)hist[tid], __ATOMIC_RELAXED, __HIP_MEMORY_SCOPE_AGENT);
        __syncthreads();
        if (tid < 256) {
            const int rowi = tid >> 2, k = tid & 3, pk = tmp[tid], ee = pk >> 16, p = base[ee] + (pk & 0xffff), tok = blk * 64 + rowi;
            list[((size_t)ee * M + p) * 2] = tok; list[((size_t)ee * M + p) * 2 + 1] = __float_as_int(tmpr[rowi]);
            tokinfo[tok * 4 + k] = (ee << 16) | p; tgate[tok * 4 + k] = tmpg[tid];
        }
        __syncthreads();
    }
}
DI void moe_tables(Frame& F, LAS int*& tstart, LAS int*& ecnt) {
    const int tid = F.wave * 64 + lane_id();
    tstart = (LAS int*)(F.lds + AUX_OFF + 8192); ecnt = tstart + 64;
    if (tid == 0) { int a = 0; for (int e = 0; e < 32; ++e) { const int c = (int)__hip_atomic_load((unsigned*)(F.ctl + CW_CNT + e), __ATOMIC_RELAXED, __HIP_MEMORY_SCOPE_AGENT); tstart[e] = a; ecnt[e] = c; a += (c + 255) >> 8; } tstart[32] = a; }
    __syncthreads();
}
DI void final_phase(Frame& F, const LAS int* tstart) {
    const int gw = F.vcu * NWAVES + F.wave, NGW = F.G * NWAVES, lane = lane_id();
    const int* tokinfo = (const int*)(F.ws + WS_TOKINFO); const float* tgate = (const float*)(F.ws + WS_TGATE); const bf16* O2 = (const bf16*)(F.ws + WS_O2);
    for (int tok = gw; tok < M; tok += NGW) {
        f32x4* op = (f32x4*)(F.out + (size_t)tok * D) + lane;
        f32x4 a[4];
#pragma unroll
        for (int j = 0; j < 4; ++j) a[j] = op[64 * j];
#pragma unroll
        for (int k = 0; k < 4; ++k) {
            const int info = tokinfo[tok * 4 + k]; const float gk = tgate[tok * 4 + k];
            const size_t rowk = (size_t)tstart[info >> 16] * 256 + (info & 0xffff);
            const u32x2* o2 = (const u32x2*)(O2 + rowk * 1024) + lane;
#pragma unroll
            for (int j = 0; j < 4; ++j) { const u32x2 w = o2[64 * j]; a[j].x += gk * bflo(w.x); a[j].y += gk * bfhi(w.x); a[j].z += gk * bflo(w.y); a[j].w += gk * bfhi(w.y); }
        }
#pragma unroll
        for (int j = 0; j < 4; ++j) op[64 * j] = a[j];
    }
}

#ifndef MK_SPLIT
#define MK_SPLIT 0
#endif
constexpr int NPHASE = 10;
struct Args { const float* in[23]; float* out; unsigned char* ws; int ph_lo, ph_hi; };
__global__ void __launch_bounds__(NWAVES * 64, 2) mk_fwd(Args args) {
    extern __shared__ __attribute__((aligned(16))) unsigned char lds[];
    Frame F;
    F.lds = (LAS unsigned char*)lds; F.MISC = (volatile LAS unsigned*)(F.lds + MISC_OFF);
    F.wave = __builtin_amdgcn_readfirstlane((int)threadIdx.x >> 6);
    F.G = gridDim.x; { const int bx = blockIdx.x; F.vcu = (F.G % 8 == 0) ? (bx % 8) * (F.G / 8) + bx / 8 : bx; }
    F.ka = (kptr_t)__builtin_amdgcn_kernarg_segment_ptr();
    F.out = args.out; F.ws = args.ws; F.ctl = (gu32*)(args.ws + WS_CTL);
    unsigned char* ws = args.ws;
    { const int tid0 = threadIdx.x; if (tid0 < 128) ((LAS unsigned*)(F.lds + MISC_OFF))[tid0] = 0u; }
    __syncthreads();
    XcdBarrier bar; bar.bar = (unsigned*)(F.ctl + CW_BAR); bar.x = 0; bar.st = nullptr;
    if (!MK_SPLIT) bar = xcd_barrier_post((unsigned*)(F.ctl + CW_BAR), F.MISC + 8, F.wave == 0 && lane_id() == 0);
    const int lo = args.ph_lo, hi = args.ph_hi;
#ifndef ONLY_PHASE
#define ONLY_PHASE -1
#endif
#define IN(k) ((ONLY_PHASE < 0 || ONLY_PHASE == (k)) && lo <= (k) && (k) < hi)
#define SEAM(k) do { if (IN(k) && IN((k) + 1)) xcd_barrier(bar, F.wave == 0 && lane_id() == 0); } while (0)

    if (IN(0)) { p0_prologue(F); }
    SEAM(0);
    if (IN(1)) {
        StaticOrder S; S.init(ws + WS_XN, ws + WS_WIN, M, NZP, D, F.G, (int)blockIdx.x);
        EpiWin E{(bf16*)(ws + WS_Q), (bf16*)(ws + WS_KCH), (bf16*)(ws + WS_VCH), (bf16*)(ws + WS_KS), (bf16*)(ws + WS_VS), (bf16*)(ws + WS_KW), (bf16*)(ws + WS_VW),
                 (bf16*)(ws + WS_U), (bf16*)(ws + WS_VG), (float*)(ws + WS_GATES), (float*)(ws + WS_VSSQ), fin(F, 3), fin(F, 4)};
        pg8::gemm_phase<EpiWin, StaticOrder, true>(F.lds, D, S, E, F.wave);
    }
    SEAM(1);
    if (IN(2)) {
        gmlp_phase(F);
        CmpOrder S; S.idx = F.vcu - 128; S.A0 = (const char*)(ws + WS_KCH); S.A1 = (const char*)(ws + WS_VCH); S.B = (const char*)(ws + WS_WCMP);
        EpiCmp E{(float*)(ws + WS_TCMP)};
        pg8::gemm_phase<EpiCmp, CmpOrder, false>(F.lds, 1024, S, E, F.wave);
    }
    SEAM(2);
    if (IN(3)) { cmp2_phase(F); }
    SEAM(3);
    if (IN(4)) { attn_phase(F); }
    SEAM(4);
    if (IN(5)) {
        StaticOrder S; S.init(ws + WS_MIXED, ws + WS_WOUT, M, D, D, F.G, (int)blockIdx.x);
        EpiWout E{fin(F, 0), F.out, (bf16*)(ws + WS_XN)};
        pg8::gemm_phase<EpiWout, StaticOrder, true>(F.lds, D, S, E, F.wave);
    }
    SEAM(5);
    if (IN(6)) { route_phase(F); }
    SEAM(6);
    LAS int* tstart = nullptr; LAS int* ecnt = nullptr;
    if (IN(7)) {
        moe_tables(F, tstart, ecnt);
        MoeOrder<8, true> S; S.G = F.G; S.c = (int)blockIdx.x; S.utot = tstart[32] * 8; S.tstart = tstart; S.ecnt = ecnt;
        S.A = (const char*)(ws + WS_XN); S.B = (const char*)(ws + WS_WGU); S.bexp = (size_t)2048 * 1024 * 2; S.list = (const int*)(ws + WS_LIST); S.stash = F.lds + AUX_OFF;
        EpiG1 E{(bf16*)(ws + WS_H), fin(F, 20), (const int*)(ws + WS_LIST)};
        pg8::gemm_phase<EpiG1, MoeOrder<8, true>, true>(F.lds, D, S, E, F.wave);
    }
    SEAM(7);
    if (IN(8)) {
        moe_tables(F, tstart, ecnt);
        MoeOrder<4, false> S; S.G = F.G; S.c = (int)blockIdx.x; S.utot = tstart[32] * 4; S.tstart = tstart; S.ecnt = ecnt;
        S.A = (const char*)(ws + WS_H); S.B = (const char*)(ws + WS_WD); S.bexp = (size_t)1024 * 1024 * 2; S.list = nullptr; S.stash = nullptr;
        EpiG2 E{(bf16*)(ws + WS_O2), fin(F, 22)};
        pg8::gemm_phase<EpiG2, MoeOrder<4, false>, true>(F.lds, DEXP, S, E, F.wave);
    }
    SEAM(8);
    if (IN(9)) { moe_tables(F, tstart, ecnt); final_phase(F, tstart); }
#undef IN
#undef SEAM
}

extern "C" void kernel_launch(void* const* d_in, const int* in_sizes, int n_in, void* d_out, int out_size, void* d_ws, size_t ws_size, hipStream_t stream) {
    static int grid = 0;
    if (grid == 0) {
        if (n_in != 23 || out_size != M * D || ws_size < WS_END) { fprintf(stderr, "kernel_launch: unexpected shapes (n_in %d out %d ws %zu)\n", n_in, out_size, ws_size); grid = -1; return; }
        int dev = 0, cus = 0, per_cu = 0;
        hipGetDevice(&dev); hipDeviceGetAttribute(&cus, hipDeviceAttributeMultiprocessorCount, dev);
        if (hipFuncSetAttribute((const void*)mk_fwd, hipFuncAttributeMaxDynamicSharedMemorySize, LDS_BYTES) != hipSuccess) { fprintf(stderr, "kernel_launch: hipFuncSetAttribute failed\n"); grid = -1; return; }
        hipOccupancyMaxActiveBlocksPerMultiprocessor(&per_cu, (const void*)mk_fwd, NWAVES * 64, LDS_BYTES);
        (void)hipGetLastError();
        if (per_cu < 1) { fprintf(stderr, "kernel_launch: occupancy query says %d blocks per CU\n", per_cu); grid = -1; return; }
        grid = cus;
    }
    if (grid < 0) return;
    hipMemsetAsync((char*)d_ws + WS_CTL, 0, CTL_ZERO_BYTES, stream);
    Args a{};
    for (int i = 0; i < 23; ++i) a.in[i] = (const float*)d_in[i];
    a.out = (float*)d_out; a.ws = (unsigned char*)d_ws;
#if MK_SPLIT
    for (int p = 0; p < NPHASE; ++p) { a.ph_lo = p; a.ph_hi = p + 1; hipLaunchKernelGGL(mk_fwd, dim3(grid), dim3(NWAVES * 64), LDS_BYTES, stream, a); }
#else
    a.ph_lo = 0; a.ph_hi = NPHASE;
    void* kargs[] = {&a};
    hipError_t e = hipLaunchCooperativeKernel((const void*)mk_fwd, dim3(grid), dim3(NWAVES * 64), kargs, LDS_BYTES, stream);
    if (e != hipSuccess) fprintf(stderr, "kernel_launch: cooperative launch failed: %s (grid %d)\n", hipGetErrorString(e), grid);
#endif
}
```

```cpp
#include <hip/hip_runtime.h>
#include <cstdio>
#include <cstdint>

#define LAS __attribute__((address_space(3)))
#define GAS __attribute__((address_space(1)))
typedef unsigned short bf16;
typedef short bf16x8 __attribute__((ext_vector_type(8)));
typedef short s16x4 __attribute__((ext_vector_type(4)));
typedef float f32x4 __attribute__((ext_vector_type(4)));
typedef float f32x2 __attribute__((ext_vector_type(2)));
typedef float f32x16 __attribute__((ext_vector_type(16)));
typedef unsigned u32x4 __attribute__((ext_vector_type(4)));
typedef unsigned u32x2 __attribute__((ext_vector_type(2)));
typedef __bf16 bf16x2_t __attribute__((ext_vector_type(2)));
typedef GAS unsigned gu32;

#define DI __device__ __forceinline__
DI unsigned pk2(float lo, float hi) { f32x2 v = {lo, hi}; bf16x2_t b = __builtin_convertvector(v, bf16x2_t); return __builtin_bit_cast(unsigned, b); }
DI int lane_id() { return (int)__builtin_amdgcn_mbcnt_hi(~0u, __builtin_amdgcn_mbcnt_lo(~0u, 0u)); }
DI unsigned pk4_fp8(float a, float b, float c, float d) { unsigned w = 0; w = __builtin_amdgcn_cvt_pk_fp8_f32(a, b, w, false); w = __builtin_amdgcn_cvt_pk_fp8_f32(c, d, w, true); return w; }
DI float bf2f(unsigned short x) { return __uint_as_float((unsigned)x << 16); }
DI float bflo(unsigned w) { return __uint_as_float(w << 16); }
DI float bfhi(unsigned w) { return __uint_as_float(w & 0xffff0000u); }
DI float wave_sum(float v) {
#pragma unroll
    for (int o = 1; o < 64; o <<= 1) v += __shfl_xor(v, o);
    return v;
}
DI float gelu_tanh(float x) {
    const float u = x * (1.0f + 0.044715f * x * x);
    return x * __builtin_amdgcn_rcpf(1.0f + __builtin_amdgcn_exp2f(-2.3022082f * u));
}
DI float sigmoidf_(float x) { return __builtin_amdgcn_rcpf(1.0f + __builtin_amdgcn_exp2f(-1.44269504f * x)); }

#ifndef MK_NTB
#define MK_NTB 0
#endif
namespace pg8 {
constexpr int BM = 256, BK = 64, HALF = 128, HTB = HALF * BK * 2, STAGE_BYTES = 8 * HTB, NXCD = 8, WGM = 8;
__host__ __device__ __forceinline__ int lds_byte(int r, int c) { const int st = (r >> 4) * 2 + (c >> 5), rr = r & 15, cc = c & 31, ob = rr * 64 + cc * 2; return st * 1024 + (ob ^ (((ob >> 9) & 1) << 5)); }
__host__ __device__ __forceinline__ void stage_rc(int b, int& R, int& C) { const int st = b / 1024, sb = b % 1024, swz = sb ^ (((sb >> 9) & 1) << 5); R = (st >> 1) * 16 + swz / 64; C = (st & 1) * 32 + (swz % 64) / 2; }
__host__ __device__ __forceinline__ int perm32(int rho) { const int n = rho >> 4, i = rho & 15; return 8 * (i >> 2) + 4 * n + (i & 3); }

struct Unit { int pm, pn, e, ml, cnt; };
struct Src { const char* a; const char* b; unsigned ao[2][2]; };

typedef int v8i __attribute__((ext_vector_type(8)));
typedef int v4i __attribute__((ext_vector_type(4)));
__device__ __forceinline__ v8i cat8(bf16x8 a, bf16x8 b) { const v4i x = __builtin_bit_cast(v4i, a), y = __builtin_bit_cast(v4i, b); return __builtin_shufflevector(x, y, 0, 1, 2, 3, 4, 5, 6, 7); }
typedef short s16x16 __attribute__((ext_vector_type(16)));
typedef s16x16 s16x16_a16 __attribute__((aligned(16)));
template <class Epi, class Sched, bool ALIGN_EPI, bool FP8>
__device__ __forceinline__ void gemm_phase(LAS unsigned char* lds, const int KB, const Sched& S, const Epi& E, const int wid) {
    const int lane = lane_id(), tid = wid * 64 + lane, wr = wid >> 2, wc = wid & 3, fr = lane & 15, fq = lane >> 4;
    const int nt = KB / 128;
    unsigned voffB[2];
#pragma unroll
    for (int i = 0; i < 2; ++i) { int R, C; stage_rc(tid * 16 + i * 8192, R, C); const int Rb = Epi::PERM ? ((R & ~31) + perm32(R & 31)) : R;
        voffB[i] = (unsigned)(Rb * KB + C * 2); }
    const size_t kstep = (size_t)(BK * 2);
    const size_t hstep = (size_t)HALF * KB;
    const unsigned ldsw = (unsigned)wid * 1024u;
    const int aoff = FP8 ? lds_byte(wr * 64 + fr, fq * 16) : lds_byte(wr * 64 + fr, fq * 8), boff = FP8 ? lds_byte(wc * 32 + fr, fq * 16) : lds_byte(wc * 32 + fr, fq * 8);
#define PG8_SA(b, h) (((b) * 2 + (h)) * HTB)
#define PG8_SB(b, h) ((4 + (b) * 2 + (h)) * HTB)
#define PG8_GLDS(src, dstoff) __builtin_amdgcn_global_load_lds((const unsigned*)(src), (LAS unsigned*)(lds + (dstoff)), 16, 0, 0)
#define PG8_GLDS_NT(src, dstoff) __builtin_amdgcn_global_load_lds((const unsigned*)(src), (LAS unsigned*)(lds + (dstoff)), 16, 0, 2)
#define PG8_STAGE_B(bufoff, gbase) do { _Pragma("unroll") for (int _i = 0; _i < 2; ++_i) { if constexpr (FP8 && MK_NTB) PG8_GLDS_NT((const char*)(gbase) + voffB[_i], (bufoff) + ldsw + _i * 8192); else PG8_GLDS((const char*)(gbase) + voffB[_i], (bufoff) + ldsw + _i * 8192); } } while (0)
#define PG8_STAGE_A(bufoff, gbase, o0, o1) do { PG8_GLDS((const char*)(gbase) + (o0), (bufoff) + ldsw); PG8_GLDS((const char*)(gbase) + (o1), (bufoff) + ldsw + 8192); } while (0)
#define PG8_LDA(dst, b, h) do { _Pragma("unroll") for (int m = 0; m < 4; ++m) _Pragma("unroll") for (int k = 0; k < 2; ++k) dst[m][k] = *(const LAS bf16x8*)(lds + PG8_SA(b, h) + aoff + m * 2048 + (FP8 ? k * 16 : k * 1024)); } while (0)
#define PG8_LDB(dst, b, h) do { _Pragma("unroll") for (int n = 0; n < 2; ++n) _Pragma("unroll") for (int k = 0; k < 2; ++k) dst[n][k] = *(const LAS bf16x8*)(lds + PG8_SB(b, h) + boff + n * 2048 + (FP8 ? k * 16 : k * 1024)); } while (0)
#define PG8_MMA(ai, bj, At, Bt) do { __builtin_amdgcn_s_setprio(1); _Pragma("unroll") for (int m = 0; m < 4; ++m) _Pragma("unroll") for (int n = 0; n < 2; ++n) { \
        if constexpr (FP8) { asm volatile("v_mfma_scale_f32_16x16x128_f8f6f4 %0, %1, %2, %0, %3, %3 op_sel_hi:[0,0,0]" : "+v"(acc[ai][bj][m][n]) : "v"(cat8(Bt[n][0], Bt[n][1])), "v"(cat8(At[m][0], At[m][1])), "v"(scale1)); } \
        else { _Pragma("unroll") for (int k = 0; k < 2; ++k) acc[ai][bj][m][n] = __builtin_amdgcn_mfma_f32_16x16x32_bf16(Bt[n][k], At[m][k], acc[ai][bj][m][n], 0, 0, 0); } } __builtin_amdgcn_s_setprio(0); } while (0)
#define PG8_WAIT_V(n) asm volatile("s_waitcnt vmcnt(" #n ")" ::: "memory")
#define PG8_WAIT_L(n) asm volatile("s_waitcnt lgkmcnt(" #n ")" ::: "memory")
#define PG8_BAR __builtin_amdgcn_s_barrier()
#define PG8_SCHED __builtin_amdgcn_sched_barrier(0)
    Unit cur, nxt; int ui = 0;
    if (!S.next(0, cur)) return;
    Src sc, sn;
    S.fill(cur, sc, tid);
    f32x4 acc[2][2][4][2];
#pragma unroll
    for (int a = 0; a < 2; ++a)
#pragma unroll
        for (int b = 0; b < 2; ++b)
#pragma unroll
            for (int m = 0; m < 4; ++m)
#pragma unroll
                for (int n = 0; n < 2; ++n) acc[a][b][m][n] = (f32x4){0.f, 0.f, 0.f, 0.f};
    bf16x8 At[4][2], B0[2][2], B1[2][2];
    int scale1 = 0x7F7F7F7F; asm volatile("" : "+v"(scale1));
    PG8_STAGE_B(PG8_SB(0, 0), sc.b); PG8_STAGE_B(PG8_SB(0, 1), sc.b + hstep); PG8_STAGE_A(PG8_SA(0, 0), sc.a, sc.ao[0][0], sc.ao[0][1]); PG8_STAGE_A(PG8_SA(0, 1), sc.a, sc.ao[1][0], sc.ao[1][1]);
    if (wr == 1) PG8_BAR;
    PG8_WAIT_V(2); PG8_BAR;
    PG8_STAGE_B(PG8_SB(1, 0), sc.b + kstep); PG8_STAGE_A(PG8_SA(1, 0), sc.a + kstep, sc.ao[0][0], sc.ao[0][1]); PG8_STAGE_B(PG8_SB(1, 1), sc.b + hstep + kstep);
    PG8_WAIT_V(6); PG8_BAR;
    for (;;) {
        const bool has_next = S.next(ui + 1, nxt);
        if (has_next) S.fill(nxt, sn, tid); else sn = sc;
        if constexpr (Sched::GATHER) { *(LAS u32x4*)(S.stash + tid * 16) = (u32x4){sn.ao[0][0], sn.ao[0][1], sn.ao[1][0], sn.ao[1][1]}; }
        for (int t = 0; t < nt; t += 2) {
            const bool last = (t == nt - 2);
            const char* a1 = sc.a + (size_t)(t + 1) * kstep;
            const char* a2 = last ? sn.a : sc.a + (size_t)(t + 2) * kstep; const char* b2 = last ? sn.b : sc.b + (size_t)(t + 2) * kstep;
            const char* a3 = a2 + kstep; const char* b3 = b2 + kstep;
            unsigned o00, o01, o10, o11;
            if constexpr (Sched::GATHER) { o00 = sc.ao[0][0]; o01 = sc.ao[0][1]; o10 = sc.ao[1][0]; o11 = sc.ao[1][1];
                if (last) { const u32x4 q = *(const LAS u32x4*)(S.stash + tid * 16); o00 = q.x; o01 = q.y; o10 = q.z; o11 = q.w; } }
            else { o00 = sc.ao[0][0]; o01 = sc.ao[0][1]; o10 = sc.ao[1][0]; o11 = sc.ao[1][1]; }
            PG8_LDB(B0, 0, 0); PG8_LDB(B1, 0, 1); PG8_SCHED; PG8_LDA(At, 0, 0); PG8_STAGE_A(PG8_SA(1, 1), a1, sc.ao[1][0], sc.ao[1][1]);
            PG8_WAIT_V(8); PG8_WAIT_L(0); PG8_BAR; PG8_MMA(0, 0, At, B0); PG8_MMA(0, 1, At, B1); PG8_BAR; PG8_SCHED;
            PG8_LDA(At, 0, 1); PG8_STAGE_B(PG8_SB(0, 0), b2); PG8_STAGE_B(PG8_SB(0, 1), b2 + hstep); PG8_STAGE_A(PG8_SA(0, 0), a2, o00, o01);
            PG8_WAIT_V(8); PG8_WAIT_L(0); PG8_BAR; PG8_MMA(1, 0, At, B0); PG8_MMA(1, 1, At, B1); PG8_BAR; PG8_SCHED;
            PG8_LDB(B0, 1, 0); PG8_LDB(B1, 1, 1); PG8_SCHED; PG8_LDA(At, 1, 0); PG8_STAGE_A(PG8_SA(0, 1), a2, o10, o11);
            PG8_WAIT_V(8); PG8_WAIT_L(0); PG8_BAR; PG8_MMA(0, 0, At, B0); PG8_MMA(0, 1, At, B1); PG8_BAR; PG8_SCHED;
            PG8_LDA(At, 1, 1); PG8_STAGE_B(PG8_SB(1, 0), b3); PG8_STAGE_B(PG8_SB(1, 1), b3 + hstep); PG8_STAGE_A(PG8_SA(1, 0), a3, o00, o01);
            PG8_WAIT_V(8); PG8_WAIT_L(0); PG8_BAR; PG8_MMA(1, 0, At, B0); PG8_MMA(1, 1, At, B1); PG8_BAR; PG8_SCHED;
        }
        if constexpr (ALIGN_EPI) { if (wr == 0) PG8_BAR; }
        if constexpr (FP8) { asm volatile("s_nop 15\n\ts_nop 15" ::: "memory"); }
        E(acc, cur, wr, wc, fr, fq);
        if (!has_next) break;
#pragma unroll
        for (int a = 0; a < 2; ++a)
#pragma unroll
            for (int b = 0; b < 2; ++b)
#pragma unroll
                for (int m = 0; m < 4; ++m)
#pragma unroll
                    for (int n = 0; n < 2; ++n) acc[a][b][m][n] = (f32x4){0.f, 0.f, 0.f, 0.f};
        cur = nxt; sc.a = sn.a; sc.b = sn.b;
        if constexpr (Sched::GATHER) { const u32x4 q = *(const LAS u32x4*)(S.stash + tid * 16); sc.ao[0][0] = q.x; sc.ao[0][1] = q.y; sc.ao[1][0] = q.z; sc.ao[1][1] = q.w; }
        ++ui;
        if constexpr (ALIGN_EPI) { if (wr == 1) PG8_BAR; }
    }
    PG8_WAIT_V(0);
    if constexpr (!ALIGN_EPI) { if (wr == 0) PG8_BAR; }
    PG8_BAR;
#undef PG8_SA
#undef PG8_SB
#undef PG8_GLDS
#undef PG8_STAGE_A
#undef PG8_STAGE_B
#undef PG8_LDA
#undef PG8_LDB
#undef PG8_MMA
#undef PG8_WAIT_V
#undef PG8_WAIT_L
#undef PG8_BAR
#undef PG8_SCHED
}
}

#define XB_TMO      128
#define XB_XCNT(j)  (256  + 64 * (j))
#define XB_XSUB(j)  (1280 + 64 * (j))
#define XB_XGEN(j)  (2304 + 64 * (j))
#define XB_TOP      3328
#define XB_TOPGEN   3392
#define XCD_BAR_WORDS 3456
#define XB_SPIN_CAP (1u << 20)
DI unsigned xb_ld(unsigned* p)              { return __hip_atomic_load(p, __ATOMIC_RELAXED, __HIP_MEMORY_SCOPE_AGENT); }
DI unsigned xb_add(unsigned* p, unsigned v) { return __hip_atomic_fetch_add(p, v, __ATOMIC_RELAXED, __HIP_MEMORY_SCOPE_AGENT); }
DI unsigned xb_xcc_id() { return (unsigned)__builtin_amdgcn_s_getreg((3 << 11) | 20) & 0xFu; }
#define XB_SPIN(cond, bar) do { unsigned _sp = 0; while (cond) { __builtin_amdgcn_s_sleep(1); \
    if ((++_sp & 255u) == 0u) { if (xb_ld(&(bar)[XB_TMO])) break; if (_sp > XB_SPIN_CAP) { atomicAdd(&(bar)[XB_TMO], 1u); break; } } } } while (0)
struct XcdBarrier { unsigned* bar; unsigned x; volatile LAS unsigned* st; };
DI XcdBarrier xcd_barrier_post(unsigned* bar, volatile LAS unsigned* st, bool t0) {
    XcdBarrier b; b.bar = bar; b.x = xb_xcc_id(); b.st = st;
    if (t0) (void)xb_add(&bar[XB_XCNT(b.x)], 1u);
    return b;
}
DI void xcd_barrier_complete(unsigned* bar, unsigned x, unsigned& nloc, unsigned& nx) {
    const unsigned G = gridDim.x * gridDim.y * gridDim.z;
    unsigned sum, cnt, mine, sp = 0u;
    for (;;) {
        sum = 0u; cnt = 0u; mine = 0u;
#pragma unroll
        for (unsigned j = 0; j < 16; ++j) { const unsigned c = xb_ld(&bar[XB_XCNT(j)]); sum += c; cnt += (c > 0u) ? 1u : 0u; mine = (j == x) ? c : mine; }
        if (sum == G) break;
        __builtin_amdgcn_s_sleep(1);
        if ((++sp & 255u) == 0u) { if (xb_ld(&bar[XB_TMO])) break; if (sp > XB_SPIN_CAP) { atomicAdd(&bar[XB_TMO], 1u); break; } }
    }
    nloc = mine > 0u ? mine : 1u; nx = cnt > 0u ? cnt : 1u;
}
DI void xcd_barrier(const XcdBarrier& b, bool t0) {
    asm volatile("s_waitcnt vmcnt(0)" ::: "memory");
    __syncthreads();
    if (t0) {
        unsigned* bar = b.bar;
        __builtin_amdgcn_s_waitcnt(0);
        unsigned nloc = b.st[0], nx = b.st[1];
        if (nloc == 0u) { xcd_barrier_complete(bar, b.x, nloc, nx); b.st[0] = nloc; b.st[1] = nx; }
        const unsigned old = xb_add(&bar[XB_XSUB(b.x)], 1u);
        const unsigned gen = old / nloc;
        if (old + 1u == (gen + 1u) * nloc) {
            __builtin_amdgcn_fence(__ATOMIC_RELEASE, "agent");
            asm volatile("s_waitcnt vmcnt(0)" ::: "memory");
            const unsigned og = xb_add(&bar[XB_TOP], 1u);
            const unsigned tg = og / nx;
            if (og + 1u == (tg + 1u) * nx) xb_add(&bar[XB_TOPGEN], 1u);
            else XB_SPIN(xb_ld(&bar[XB_TOPGEN]) == tg, bar);
            __builtin_amdgcn_fence(__ATOMIC_ACQUIRE, "agent");
            xb_add(&bar[XB_XGEN(b.x)], 1u);
            asm volatile("s_waitcnt vmcnt(0)" ::: "memory");
        } else {
            XB_SPIN(xb_ld(&bar[XB_XGEN(b.x)]) == gen, bar);
            __builtin_amdgcn_fence(__ATOMIC_ACQUIRE, "agent");
            asm volatile("s_waitcnt vmcnt(0)" ::: "memory");
        }
    }
    __syncthreads();
}

constexpr int NWAVES = 8;
constexpr int BATCH = 2, T = 8192, D = 1024, M = BATCH * T;
constexpr int NZP = 2560;
constexpr int NEXP = 32, DEXP = 1024;
constexpr int PMAX = M * 4 + NEXP * 256;
constexpr float EPS = 1e-6f;
constexpr float LOG2E = 1.4426950408889634f;
constexpr float QSCALE = 0.125f * LOG2E;

constexpr size_t MiB = 1u << 20;
constexpr size_t WS_CTL = 0, CTL_ZERO_BYTES = 1 * MiB;
constexpr int CW_BAR = 4096;
constexpr int CW_CNT = 8192;
constexpr size_t WS_VSSQ = 256 * 1024;
constexpr size_t WS_WIN = 2 * MiB, WS_WOUT = 8 * MiB, WS_WCMP = 10 * MiB, WS_C1 = 11 * MiB, WS_RINV2 = 11 * MiB + 65536;
constexpr size_t WS_GATES = 12 * MiB, WS_KCN = 14 * MiB, WS_VCC = 14 * MiB + 512 * 1024, WS_TOKINFO = 15 * MiB, WS_TGATE = 15 * MiB + 512 * 1024;
constexpr size_t WS_LIST = 16 * MiB, WS_TCMP = 20 * MiB, WS_KCH = 24 * MiB, WS_VCH = 28 * MiB;
constexpr size_t WS_KS = 32 * MiB, WS_VS = 36 * MiB, WS_KW = 40 * MiB, WS_VW = 44 * MiB, WS_Q = 48 * MiB, WS_U = 64 * MiB, WS_VG = 80 * MiB;
#ifndef MK_ALIAS
#define MK_ALIAS 0
#endif
constexpr float SWG_C = 1.702f * 1.4426950408889634f, SWG_IC = 1.0f / SWG_C;
constexpr size_t WS_XN = 96 * MiB, WS_MIXED = 128 * MiB, WS_WGU = 160 * MiB  , WS_X1B = 224 * MiB  , WS_WD = 248 * MiB  ,
                 WS_H = MK_ALIAS ? 32 * MiB : 280 * MiB  , WS_O2 = MK_ALIAS ? 104 * MiB : 352 * MiB  , WS_X1H = 424 * MiB  , WS_END = 496 * MiB;
constexpr float WSCALE = 32.0f, WSCALE_INV = 1.0f / 32.0f, O2SCALE = 16.0f, O2SCALE_INV = 1.0f / 16.0f;

constexpr int RING_BYTES = 131072;
constexpr int LDS_BYTES = 163840;
constexpr int MISC_OFF = LDS_BYTES - 512;
constexpr int AUX_OFF = 147456;

struct Frame {
    LAS unsigned char* lds; volatile LAS unsigned* MISC; gu32* ctl;
    int wave, vcu, G;
    float* out; unsigned char* ws;
    const __attribute__((address_space(4))) char* ka;
};
typedef const __attribute__((address_space(4))) char* kptr_t;
DI const float* fin(const Frame& F, int i) { kptr_t ka = F.ka; asm volatile("" : "+s"(ka)); return *(const float* const __attribute__((address_space(4)))*)(ka + 8 * i); }

struct StaticOrder {
    static constexpr bool GATHER = false;
    int nM, nN, nwg, G, c, KB; const char* A; const char* B;
    DI void init(const void* A_, const void* B_, int M_, int N_, int KB_, int G_, int c_) { A = (const char*)A_; B = (const char*)B_; nM = M_ / 256; nN = N_ / 256; nwg = nM * nN; G = G_; c = c_; KB = KB_; }
    DI bool next(int i, pg8::Unit& u) const {
        const long L = (long)i * G + c; if (L >= nwg) return false;
        int wgid = (int)L; { const int q = nwg / 8, r = nwg % 8, xcd = wgid % 8, off = wgid / 8; wgid = (xcd < r ? xcd * (q + 1) : r * (q + 1) + (xcd - r) * q) + off; }
        const int nig = 8 * nN, gid = wgid / nig, fm = gid * 8, gsz = (nM - fm) < 8 ? (nM - fm) : 8;
        u.pm = fm + ((wgid % nig) % gsz); u.pn = (wgid % nig) / gsz; u.e = 0; u.ml = 0; u.cnt = 0; return true;
    }
    DI void fill(const pg8::Unit& u, pg8::Src& s, int tid) const {
        int RA[2]; unsigned CA2[2];
        for (int i = 0; i < 2; ++i) { int R, C; pg8::stage_rc(tid * 16 + i * 8192, R, C); RA[i] = R; CA2[i] = (unsigned)C * 2u; }
        const size_t tstep = (size_t)256 * KB;
        s.a = A + (size_t)u.pm * tstep; s.b = B + (size_t)u.pn * tstep;
#pragma unroll
        for (int h = 0; h < 2; ++h)
#pragma unroll
            for (int i = 0; i < 2; ++i) s.ao[h][i] = (unsigned)((h * 128 + RA[i]) * KB) + CA2[i];
    }
};
struct CmpOrder {
    static constexpr bool GATHER = false;
    int idx; const char* A0; const char* A1; const char* B;
    DI bool next(int i, pg8::Unit& u) const { if (i > 0 || idx < 0 || idx >= 16) return false; u.e = idx >> 3; u.pm = idx & 7; u.pn = 0; u.ml = 0; u.cnt = 0; return true; }
    DI void fill(const pg8::Unit& u, pg8::Src& s, int tid) const {
        int RA[2]; unsigned CA2[2];
        for (int i = 0; i < 2; ++i) { int R, C; pg8::stage_rc(tid * 16 + i * 8192, R, C); RA[i] = R; CA2[i] = (unsigned)C * 2u; }
        const size_t tstep = (size_t)256 * 1024 * 2;
        s.a = (u.e ? A1 : A0) + (size_t)u.pm * tstep; s.b = B + (size_t)u.e * tstep;
#pragma unroll
        for (int h = 0; h < 2; ++h)
#pragma unroll
            for (int i = 0; i < 2; ++i) s.ao[h][i] = (unsigned)((h * 128 + RA[i]) * 1024) * 2u + CA2[i];
    }
};
template <int NT, bool GATH, int DBG = 0> struct MoeOrder {
    static constexpr bool GATHER = GATH;
    int G, c, utot; const LAS int* tstart; const LAS int* ecnt; const char* A; const char* B; size_t bexp; const int* list; LAS unsigned char* stash; int dbg;
    DI bool next(int i, pg8::Unit& u) const {
        int tau, nt;
        if ((G & 7) == 0 && (G >> 3) % NT == 0) { const int x = c & 7, s = c >> 3, spx = G >> 3, tpx = spx / NT;
            tau = (i * 8 + x) * tpx + s / NT; nt = s % NT; }
        else { const int L = i * G + c; nt = L % NT; tau = L / NT; }
        if (tau * NT >= utot) return false;
        int e = 0;
        while (e < 31 && tstart[e + 1] <= tau) ++e;
        u.pm = tau; u.pn = nt; u.e = e; u.ml = tau - tstart[e]; u.cnt = ecnt[e]; return true;
    }
    DI void fill(const pg8::Unit& u, pg8::Src& s, int tid) const {
        int RA[2]; unsigned CA2[2];
        for (int i = 0; i < 2; ++i) { int R, C; pg8::stage_rc(tid * 16 + i * 8192, R, C); RA[i] = R; CA2[i] = (unsigned)C * 2u; }
        const size_t tstep = (size_t)256 * 1024;
        s.b = B + (size_t)u.e * bexp + (size_t)u.pn * tstep;
        if constexpr (GATH) {
            s.a = A;
#pragma unroll
            for (int h = 0; h < 2; ++h)
#pragma unroll
                for (int i = 0; i < 2; ++i) { const int r = u.ml * 256 + h * 128 + RA[i]; int tok = (DBG == 2) ? (r & 16383) : list[((size_t)u.e * M + r) * 2]; tok = (r < u.cnt) ? tok : 0; s.ao[h][i] = (unsigned)tok * 1024u + CA2[i]; }
        } else {
            s.a = A + (size_t)u.pm * tstep;
#pragma unroll
            for (int h = 0; h < 2; ++h)
#pragma unroll
                for (int i = 0; i < 2; ++i) s.ao[h][i] = (unsigned)((h * 128 + RA[i]) * 1024) + CA2[i];
        }
    }
};

struct EpiWin {
    static constexpr bool PERM = true;
    bf16 *Q, *KCH, *VCH, *KS, *VS, *KW, *VW, *U, *VG; float *GATES, *vssq; const float *qg, *kg; int noatomic;
    DI void operator()(const f32x4 (&acc)[2][2][4][2], const pg8::Unit& u, int wr, int wc, int fr, int fq) const {
        const int hu = u.pn * 4 + wc;
        if (hu > 36) return;
        const int rowb = u.pm * 256 + wr * 64 + fr;
        int kind; bf16* dst = nullptr; bool tokmajor = true; int sub = 0; const float* gain = nullptr; float gsc = 1.f;
        if (hu < 8) { kind = 0; dst = Q; sub = hu; gain = qg; gsc = QSCALE; }
        else if (hu < 20) { const int w = (hu - 8) >> 1; sub = (hu - 8) & 1; tokmajor = false;
            if (w == 0) { kind = 1; dst = KCH; } else if (w == 1) { kind = 1; dst = VCH; } else if (w == 2) { kind = 0; dst = KS; gain = kg + 64; }
            else if (w == 3) { kind = 1; dst = VS; } else if (w == 4) { kind = 0; dst = KW; gain = kg + 128; } else { kind = 1; dst = VW; } }
        else if (hu < 28) { kind = 2; dst = U; sub = hu - 20; }
        else if (hu < 36) { kind = 3; dst = VG; sub = hu - 28; }
        else kind = 4;
        float gv[2][8];
        if (kind == 0) {
#pragma unroll
            for (int bj = 0; bj < 2; ++bj)
#pragma unroll
                for (int i = 0; i < 8; ++i) gv[bj][i] = gain[32 * bj + 8 * fq + i] * gsc;
        }
#pragma unroll
        for (int ai = 0; ai < 2; ++ai)
#pragma unroll
            for (int m = 0; m < 4; ++m) {
                const int row = rowb + ai * 128 + m * 16;
                float x[2][8];
#pragma unroll
                for (int bj = 0; bj < 2; ++bj)
#pragma unroll
                    for (int n = 0; n < 2; ++n)
#pragma unroll
                        for (int i = 0; i < 4; ++i) x[bj][4 * n + i] = acc[ai][bj][m][n][i];
                if (kind == 4) {
                    if (fq < 3) {
                        f32x4 a, b;
#pragma unroll
                        for (int i = 0; i < 4; ++i) { a[i] = sigmoidf_(x[0][i]); b[i] = sigmoidf_(x[0][4 + i]); }
                        *(f32x4*)(GATES + (size_t)row * 24 + 8 * fq) = a; *(f32x4*)(GATES + (size_t)row * 24 + 8 * fq + 4) = b;
                    }
                    continue;
                }
                if (kind == 0) {
                    float s = 0.f;
#pragma unroll
                    for (int bj = 0; bj < 2; ++bj)
#pragma unroll
                        for (int i = 0; i < 8; ++i) s += x[bj][i] * x[bj][i];
                    s += __shfl_xor(s, 16); s += __shfl_xor(s, 32);
                    const float rinv = __builtin_amdgcn_rsqf(s * (1.0f / 64.0f) + EPS);
#pragma unroll
                    for (int bj = 0; bj < 2; ++bj)
#pragma unroll
                        for (int i = 0; i < 8; ++i) x[bj][i] = x[bj][i] * rinv * gv[bj][i];
                } else if (kind >= 2) {
#pragma unroll
                    for (int bj = 0; bj < 2; ++bj)
#pragma unroll
                        for (int i = 0; i < 8; ++i) x[bj][i] = gelu_tanh(x[bj][i]);
                    if (kind == 3) {
                        float s = 0.f;
#pragma unroll
                        for (int bj = 0; bj < 2; ++bj)
#pragma unroll
                            for (int i = 0; i < 8; ++i) s += x[bj][i] * x[bj][i];
                        s += __shfl_xor(s, 16); s += __shfl_xor(s, 32);
                        if (fq == 0 && !noatomic) atomicAdd(vssq + row, s);
                    }
                }
                const size_t off = tokmajor ? ((size_t)row * 512 + sub * 64) : ((size_t)(row + ((row >> 13) + sub) * 8192) * 64);
#pragma unroll
                for (int bj = 0; bj < 2; ++bj) {
                    u32x4 w; w.x = pk2(x[bj][0], x[bj][1]); w.y = pk2(x[bj][2], x[bj][3]); w.z = pk2(x[bj][4], x[bj][5]); w.w = pk2(x[bj][6], x[bj][7]);
                    *(u32x4*)(dst + off + 32 * bj + 8 * fq) = w;
                }
            }
    }
};
struct EpiCmp {
    static constexpr bool PERM = false;
    float* Tc;
    DI void operator()(const f32x4 (&acc)[2][2][4][2], const pg8::Unit& u, int wr, int wc, int fr, int fq) const {
        float* base = Tc + (size_t)u.e * 2048 * 256;
#pragma unroll
        for (int ai = 0; ai < 2; ++ai)
#pragma unroll
            for (int m = 0; m < 4; ++m) { const int row = u.pm * 256 + ai * 128 + wr * 64 + m * 16 + fr;
#pragma unroll
                for (int bj = 0; bj < 2; ++bj)
#pragma unroll
                    for (int n = 0; n < 2; ++n) *(f32x4*)(base + (size_t)row * 256 + bj * 128 + wc * 32 + n * 16 + 4 * fq) = acc[ai][bj][m][n]; }
    }
};
struct EpiWout {
    static constexpr bool PERM = true;
    const float* x; unsigned char* X1H; unsigned char* X1B;
    DI void operator()(const f32x4 (&acc)[2][2][4][2], const pg8::Unit& u, int wr, int wc, int fr, int fq) const {
#pragma unroll
        for (int ai = 0; ai < 2; ++ai)
#pragma unroll
            for (int m = 0; m < 4; ++m) { const size_t row = (size_t)u.pm * 256 + ai * 128 + wr * 64 + m * 16 + fr;
#pragma unroll
                for (int bj = 0; bj < 2; ++bj) { const size_t o = row * 1024 + u.pn * 256 + bj * 128 + wc * 32 + 8 * fq;
                    const f32x4 v0 = __builtin_nontemporal_load((const f32x4*)(x + o)) + acc[ai][bj][m][0], v1 = __builtin_nontemporal_load((const f32x4*)(x + o + 4)) + acc[ai][bj][m][1];
                    u32x4 h; h.x = pk2(v0[0], v0[1]); h.y = pk2(v0[2], v0[3]); h.z = pk2(v1[0], v1[1]); h.w = pk2(v1[2], v1[3]); *(u32x4*)(X1H + o * 2) = h;
                    u32x2 q; q.x = pk4_fp8(v0[0], v0[1], v0[2], v0[3]); q.y = pk4_fp8(v1[0], v1[1], v1[2], v1[3]); *(u32x2*)(X1B + o) = q; } }
    }
};
template <int DBG> struct EpiG1T {
    static constexpr bool PERM = true;
    unsigned char* H; const float* bias; const int* list; int dbg;
    DI void operator()(const f32x4 (&acc)[2][2][4][2], const pg8::Unit& u, int wr, int wc, int fr, int fq) const {
        if constexpr (DBG == 1) return;
        const float* bb = bias + (size_t)u.e * 2048 + u.pn * 256 + wc * 32 + 8 * fq;
        f32x4 bv[2][2];
#pragma unroll
        for (int bj = 0; bj < 2; ++bj)
#pragma unroll
            for (int n = 0; n < 2; ++n) { const f32x4 b = *(const f32x4*)(bb + bj * 128 + 4 * n); bv[bj][n] = (f32x4){b[0] * SWG_C, (b[1] + 1.0f) * SWG_IC, b[2] * SWG_C, (b[3] + 1.0f) * SWG_IC}; }
        const int* lp = list + ((size_t)u.e * M + u.ml * 256 + wr * 64 + fr) * 2 + 1;
#pragma unroll
        for (int ai = 0; ai < 2; ++ai)
#pragma unroll
            for (int m = 0; m < 4; ++m) { const int rl = ai * 128 + wr * 64 + m * 16 + fr;
                const float rinv = __int_as_float(lp[(ai * 128 + m * 16) * 2]) * WSCALE_INV;
                unsigned char* hp = H + ((size_t)u.pm * 256 + rl) * 1024 + u.pn * 128 + wc * 16 + 4 * fq;
#pragma unroll
                for (int bj = 0; bj < 2; ++bj) { float a[4];
#pragma unroll
                    for (int n = 0; n < 2; ++n) { const f32x4 v = acc[ai][bj][m][n] * rinv + bv[bj][n];
#pragma unroll
                        for (int q = 0; q < 2; ++q) { const float gl = fminf(v[2 * q], 7.0f * SWG_C), li1 = __builtin_amdgcn_fmed3f(v[2 * q + 1], -6.0f * SWG_IC, 8.0f * SWG_IC);
                            a[2 * n + q] = gl * __builtin_amdgcn_rcpf(1.0f + __builtin_amdgcn_exp2f(-gl)) * li1; } }
                    *(unsigned*)(hp + bj * 64) = pk4_fp8(a[0], a[1], a[2], a[3]); } }
    }
};
struct EpiG2 {
    static constexpr bool PERM = true;
    unsigned char* O2; const float* bias;
    DI void operator()(const f32x4 (&acc)[2][2][4][2], const pg8::Unit& u, int wr, int wc, int fr, int fq) const {
        const float* bb = bias + (size_t)u.e * 1024 + u.pn * 256 + wc * 32 + 8 * fq;
        f32x4 bv[2][2];
#pragma unroll
        for (int bj = 0; bj < 2; ++bj)
#pragma unroll
            for (int n = 0; n < 2; ++n) bv[bj][n] = *(const f32x4*)(bb + bj * 128 + 4 * n);
#pragma unroll
        for (int ai = 0; ai < 2; ++ai)
#pragma unroll
            for (int m = 0; m < 4; ++m) { const int rl = ai * 128 + wr * 64 + m * 16 + fr;
                unsigned char* op = O2 + ((size_t)u.pm * 256 + rl) * 1024 + u.pn * 256 + wc * 32 + 8 * fq;
#pragma unroll
                for (int bj = 0; bj < 2; ++bj) { const f32x4 v0 = (acc[ai][bj][m][0] * WSCALE_INV + bv[bj][0]) * O2SCALE, v1 = (acc[ai][bj][m][1] * WSCALE_INV + bv[bj][1]) * O2SCALE;
                    u32x2 w; w.x = pk4_fp8(v0[0], v0[1], v0[2], v0[3]); w.y = pk4_fp8(v1[0], v1[1], v1[2], v1[3]); *(u32x2*)(op + bj * 128) = w; } }
    }
};

#define LDS_WAIT() asm volatile("s_waitcnt lgkmcnt(0)" ::: "memory")
struct P0D { const float* src; const float* ksp; unsigned char* dst; int nsrc; float mul; bool hask; bool f8; };
DI int win_srccol(int p) {
    const int pn = p >> 8, cc = p & 255, bj = cc >> 7, wc = (cc >> 5) & 3, j = cc & 31, hu = 4 * pn + wc, dim = 32 * bj + j;
    if (hu < 20) return hu * 64 + dim;
    if (hu < 28) return 1304 + (hu - 20) * 64 + dim;
    if (hu < 36) return 1816 + (hu - 28) * 64 + dim;
    if (hu == 36 && dim < 24) return 1280 + dim;
    return -1;
}
constexpr int P0_I_GU = 32 * 8 * 64, P0_I_DN = 32 * 8 * 32, P0_I_WIN = 16 * 40, P0_I_WOUT = 16 * 16, P0_I_CMP = 128, P0_NITEMS = P0_I_GU + P0_I_DN + P0_I_WIN + P0_I_WOUT + P0_I_CMP;
struct P0Ptrs { const float *w_in, *w_cmp1, *ga, *gg, *w_out, *g2, *wgu, *wd; unsigned char* ws; };
DI P0D p0_decode(const P0Ptrs& P, int it, int lane) {
    P0D d; d.ksp = P.g2; d.hask = false; d.f8 = false; d.mul = 1.0f;
    int r = it, k0, prow0, sc, n4, q; const float* W; unsigned char* WT;
    if (r < P0_I_GU + P0_I_DN) {
        d.f8 = true; n4 = lane & 7; q = lane >> 3; d.mul = WSCALE;
        if (r < P0_I_GU) { const int e = r >> 9, kb = (r >> 6) & 7, nb = r & 63; k0 = 128 * kb; prow0 = 32 * nb; d.nsrc = 2048;
            W = P.wgu + (size_t)e * 1024 * 2048; WT = P.ws + WS_WGU + (size_t)e * 2048 * 1024; d.ksp = P.g2 + k0 + 16 * q; d.hask = true; }
        else { r -= P0_I_GU; const int e = r >> 8, kb = (r >> 5) & 7, nb = r & 31; k0 = 128 * kb; prow0 = 32 * nb; d.nsrc = 1024;
            W = P.wd + (size_t)e * 1024 * 1024; WT = P.ws + WS_WD + (size_t)e * 1024 * 1024; }
        sc = prow0 + 4 * n4;
        d.dst = WT + (size_t)prow0 * 1024 + k0;
    } else {
        r -= P0_I_GU + P0_I_DN; n4 = lane & 15; q = lane >> 4;
        if (r < P0_I_WIN) { const int kb = r / 40, nb = r % 40; k0 = 64 * kb; prow0 = 64 * nb; sc = win_srccol(prow0 + 4 * n4); d.nsrc = 2328;
            W = P.w_in; WT = P.ws + WS_WIN; }
        else if ((r -= P0_I_WIN) < P0_I_WOUT) { const int kb = r >> 4, nb = r & 15; k0 = 64 * kb; prow0 = 64 * nb; sc = prow0 + 4 * n4; d.nsrc = 1024;
            W = P.w_out; WT = P.ws + WS_WOUT; d.ksp = (k0 < 512 ? P.ga + k0 : P.gg + (k0 - 512)) + 16 * q; d.hask = true; }
        else { r -= P0_I_WOUT; const int ti = r >> 6, half = (r >> 5) & 1, kb = (r >> 1) & 15, nb = r & 1; k0 = 64 * kb; prow0 = half * 128 + 64 * nb; sc = 64 * nb + 4 * n4; d.nsrc = 128;
            W = P.w_cmp1 + (size_t)ti * 2048 * 128 + (size_t)half * 1024 * 128; WT = P.ws + WS_WCMP + (size_t)ti * 256 * 1024 * 2; }
        d.dst = WT + ((size_t)prow0 * 1024 + k0) * 2;
    }
    if (sc < 0) { d.mul = 0.0f; sc = 0; }
    d.src = W + (size_t)(k0 + 16 * q) * d.nsrc + sc;
    return d;
}
DI void p0_issue(const P0D& d, f32x4 (&v)[16], f32x4 (&ks)[4]) {
#pragma unroll
    for (int i = 0; i < 16; ++i) v[i] = __builtin_nontemporal_load((const f32x4*)(d.src + (size_t)i * d.nsrc));
#pragma unroll
    for (int i = 0; i < 4; ++i) { const f32x4 t = *(const f32x4*)(d.ksp + 4 * i); ks[i] = (d.hask ? t : (f32x4){1.f, 1.f, 1.f, 1.f}) * d.mul; }
}
DI void p0_finish(const P0D& d, const f32x4 (&v)[16], const f32x4 (&ks)[4], LAS char* tile, int lane) {
    if (d.f8) {
        const int n4 = lane & 7, q = lane >> 3;
#pragma unroll
        for (int j = 0; j < 4; ++j) {
            float x[16];
            const float pj = d.hask ? ((j & 1) ? SWG_IC : SWG_C) : 1.0f;
#pragma unroll
            for (int i = 0; i < 16; ++i) x[i] = (v[i][j] * ks[i >> 2][i & 3]) * pj;
            *(LAS u32x4*)(tile + (4 * n4 + j) * 144 + 16 * q) = (u32x4){pk4_fp8(x[0], x[1], x[2], x[3]), pk4_fp8(x[4], x[5], x[6], x[7]), pk4_fp8(x[8], x[9], x[10], x[11]), pk4_fp8(x[12], x[13], x[14], x[15])};
        }
#pragma unroll
        for (int t = 0; t < 4; ++t) { const int id = t * 64 + lane, row = id >> 3, ch = id & 7;
            const u32x4 o = *(const LAS u32x4*)(tile + row * 144 + ch * 16);
            *(u32x4*)(d.dst + (size_t)row * 1024 + ch * 16) = o; }
    } else {
        const int n4 = lane & 15, q = lane >> 4;
#pragma unroll
        for (int j = 0; j < 4; ++j) {
            float x[16];
#pragma unroll
            for (int i = 0; i < 16; ++i) x[i] = v[i][j] * ks[i >> 2][i & 3];
            LAS char* p = tile + (4 * n4 + j) * 144 + 32 * q;
            *(LAS u32x4*)p = (u32x4){pk2(x[0], x[1]), pk2(x[2], x[3]), pk2(x[4], x[5]), pk2(x[6], x[7])};
            *(LAS u32x4*)(p + 16) = (u32x4){pk2(x[8], x[9]), pk2(x[10], x[11]), pk2(x[12], x[13]), pk2(x[14], x[15])};
        }
#pragma unroll
        for (int t = 0; t < 8; ++t) { const int id = t * 64 + lane, row = id >> 3, ch = id & 7;
            const u32x4 o = *(const LAS u32x4*)(tile + row * 144 + ch * 16);
            *(u32x4*)(d.dst + (size_t)row * 2048 + ch * 16) = o; }
    }
}
DI void p0_convert(Frame& F, LAS char* tile, const int lo, const int hi, const int rank, const int stride) {
    const int lane = lane_id();
    P0Ptrs P; P.w_in = fin(F, 2); P.w_cmp1 = fin(F, 6); P.ga = fin(F, 13); P.gg = fin(F, 14); P.w_out = fin(F, 15); P.g2 = fin(F, 16); P.wgu = fin(F, 19); P.wd = fin(F, 21); P.ws = F.ws;
    f32x4 va[16], vb[16], ka[4], kb[4];
    int it = lo + rank;
    P0D da, db;
    if (it < hi) { da = p0_decode(P, it, lane); p0_issue(da, va, ka); }
    while (it < hi) {
        const int itb = it + stride;
        if (itb < hi) { db = p0_decode(P, itb, lane); p0_issue(db, vb, kb); }
        p0_finish(da, va, ka, tile, lane);
        if (itb >= hi) break;
        const int itc = itb + stride;
        if (itc < hi) { da = p0_decode(P, itc, lane); p0_issue(da, va, ka); }
        p0_finish(db, vb, kb, tile, lane);
        it = itc;
    }
}
constexpr int P0_MOE = P0_I_GU + P0_I_DN;
#ifndef MK_LATECONV
#define MK_LATECONV 0
#endif
constexpr int CV_N1 = MK_LATECONV ? 0 : 128 * 8 * 3, CV_N2 = MK_LATECONV ? 0 : 112 * 8 * 3, CV_N3 = MK_LATECONV ? 0 : 256 * 8 * 2, CV_N4 = MK_LATECONV ? 0 : 54 * 8 * 6;
constexpr int CV_LATE = MK_LATECONV ? P0_I_GU + P0_I_DN : 0;
constexpr int CV_A0 = P0_MOE - CV_LATE - (CV_N1 + CV_N2 + CV_N3 + CV_N4), CV_A1 = CV_A0 + CV_N1, CV_A2 = CV_A1 + CV_N2, CV_A3 = CV_A2 + CV_N3;
static_assert(CV_A0 >= 0 && CV_A3 + CV_N4 + CV_LATE == P0_MOE, "conversion split");
DI void p0_prologue(Frame& F) {
    const int gw = F.vcu * NWAVES + F.wave, NGW = F.G * NWAVES, lane = lane_id();
    LAS char* tile = (LAS char*)(F.lds + F.wave * 16384);
    unsigned char* ws = F.ws;
    const float* in0 = fin(F, 0); const float* in5 = fin(F, 5); const float* in6 = fin(F, 6); const float* in7 = fin(F, 7);
    p0_convert(F, tile, P0_MOE, P0_NITEMS, gw, NGW);
    p0_convert(F, tile, 0, CV_A0, gw, NGW);
    const float* g1 = fin(F, 1);
    f32x4 gv[4];
#pragma unroll
    for (int j = 0; j < 4; ++j) gv[j] = *(const f32x4*)(g1 + 4 * lane + 256 * j);
    for (int m = gw; m < M; m += NGW) {
        const f32x4* xr = (const f32x4*)(in0 + (size_t)m * D) + lane;
        f32x4 v[4]; float s = 0.f;
#pragma unroll
        for (int j = 0; j < 4; ++j) { v[j] = __builtin_nontemporal_load(xr + 64 * j); s += (v[j].x * v[j].x + v[j].y * v[j].y) + (v[j].z * v[j].z + v[j].w * v[j].w); }
        const float rinv = __builtin_amdgcn_rsqf(wave_sum(s) * (1.f / D) + EPS);
        u32x2* o8 = (u32x2*)((bf16*)(ws + WS_XN) + (size_t)m * D) + lane;
#pragma unroll
        for (int j = 0; j < 4; ++j) { const f32x4 y = v[j] * rinv * gv[j]; u32x2 w; w.x = pk2(y.x, y.y); w.y = pk2(y.z, y.w); o8[64 * j] = w; }
    }
    for (int it = gw; it < 256; it += NGW) {
        const int ti = it >> 7, n = it & 127; const float* pos = in5 + ti * 2048; const float* w1 = in6 + (size_t)ti * 2048 * 128 + n;
        float s = 0.f;
        for (int i = 0; i < 32; ++i) { const int k = lane + 64 * i; s += pos[k] * w1[(size_t)k * 128]; }
        s = wave_sum(s);
        if (lane == 0) ((float*)(ws + WS_C1))[it] = s + in7[it];
    }
}

#define MFMA32(a, b, c) __builtin_amdgcn_mfma_f32_32x32x16_bf16((a), (b), (c), 0, 0, 0)
typedef short v4i16_t __attribute__((ext_vector_type(4)));
DI s16x4 vtr(LAS const char* p) { return __builtin_bit_cast(s16x4, __builtin_amdgcn_ds_read_tr16_b64_v4i16((LAS v4i16_t*)p)); }
DI bf16x8 mk8(s16x4 lo, s16x4 hi) { return (bf16x8){lo[0], lo[1], lo[2], lo[3], hi[0], hi[1], hi[2], hi[3]}; }

DI void gmlp_phase(Frame& F) {
    const int c = F.vcu, g = F.wave, lane = lane_id(), col = lane & 31, hi = lane >> 5;
    const bool act = c < 128;
    const size_t row0 = (size_t)c * 128;
    LAS char* vl = (LAS char*)F.lds + g * 16384;
    LAS float* ssqL = (LAS float*)(F.lds + RING_BYTES);
    unsigned opk[4][2][8];
    if (act) {
        const bf16* VG = (const bf16*)(F.ws + WS_VG); const float* vssq = (const float*)(F.ws + WS_VSSQ); const float* vgain = fin(F, 10);
        const bf16* U = (const bf16*)(F.ws + WS_U);
#pragma unroll 4
        for (int i = 0; i < 16; ++i) { const int id = i * 64 + lane, s = id >> 3, ch = id & 7;
            const u32x4 raw = *(const u32x4*)(VG + (row0 + s) * 512 + g * 64 + ch * 8);
            const float rinv = __builtin_amdgcn_rsqf(vssq[row0 + s] * (1.0f / 512.0f) + EPS);
            const f32x4 ga = *(const f32x4*)(vgain + g * 64 + ch * 8), gb = *(const f32x4*)(vgain + g * 64 + ch * 8 + 4);
            u32x4 w; w.x = pk2(bflo(raw.x) * rinv * ga.x, bfhi(raw.x) * rinv * ga.y); w.y = pk2(bflo(raw.y) * rinv * ga.z, bfhi(raw.y) * rinv * ga.w);
            w.z = pk2(bflo(raw.z) * rinv * gb.x, bfhi(raw.z) * rinv * gb.y); w.w = pk2(bflo(raw.w) * rinv * gb.z, bfhi(raw.w) * rinv * gb.w);
            *(LAS u32x4*)(vl + (ch >> 2) * 8192 + s * 64 + (ch & 3) * 16) = w; }
        LAS const char* vp = vl + ((lane >> 4) & 1) * 32 + (lane & 3) * 8 + (4 * hi + ((lane & 15) >> 2)) * 64;
        const float* wsg = fin(F, 11) + (size_t)g * 128 * 128; const float* bs = fin(F, 12) + g * 128;
#pragma unroll
        for (int tb = 0; tb < 4; ++tb) {
            const int t = 32 * tb + col;
            f32x16 a0 = {}, a1 = {};
#pragma unroll
            for (int ks = 0; ks < 2 * (tb + 1); ++ks) {
                const int s0 = 16 * ks + 4 * hi;
                f32x4 wa = *(const f32x4*)(wsg + t * 128 + s0), wb = *(const f32x4*)(wsg + t * 128 + s0 + 8);
#pragma unroll
                for (int i = 0; i < 4; ++i) { wa[i] = (s0 + i <= t) ? wa[i] : 0.f; wb[i] = (s0 + 8 + i <= t) ? wb[i] : 0.f; }
                u32x4 wp; wp.x = pk2(wa[0], wa[1]); wp.y = pk2(wa[2], wa[3]); wp.z = pk2(wb[0], wb[1]); wp.w = pk2(wb[2], wb[3]);
                const bf16x8 wf = __builtin_bit_cast(bf16x8, wp);
                const bf16x8 v0 = mk8(vtr(vp + ks * 1024), vtr(vp + ks * 1024 + 512));
                const bf16x8 v1 = mk8(vtr(vp + 8192 + ks * 1024), vtr(vp + 8192 + ks * 1024 + 512));
                a0 = MFMA32(v0, wf, a0); a1 = MFMA32(v1, wf, a1);
            }
            const float bt = bs[t]; const size_t row = row0 + t; float ssq = 0.f;
#pragma unroll
            for (int db = 0; db < 2; ++db)
#pragma unroll
                for (int a = 0; a < 4; ++a) { const int d0 = 32 * db + 8 * a + 4 * hi;
                    const u32x2 uu = *(const u32x2*)(U + row * 512 + g * 64 + d0);
                    const float o0 = bflo(uu.x) * ((db ? a1[4 * a] : a0[4 * a]) + bt), o1 = bfhi(uu.x) * ((db ? a1[4 * a + 1] : a0[4 * a + 1]) + bt);
                    const float o2 = bflo(uu.y) * ((db ? a1[4 * a + 2] : a0[4 * a + 2]) + bt), o3 = bfhi(uu.y) * ((db ? a1[4 * a + 3] : a0[4 * a + 3]) + bt);
                    ssq += (o0 * o0 + o1 * o1) + (o2 * o2 + o3 * o3);
                    opk[tb][db][2 * a] = pk2(o0, o1); opk[tb][db][2 * a + 1] = pk2(o2, o3); }
            ssq += __shfl_xor(ssq, 32);
            if (hi == 0) ssqL[g * 128 + t] = ssq;
        }
    }
    __syncthreads();
    if (act) {
        bf16* MX = (bf16*)(F.ws + WS_MIXED);
#pragma unroll
        for (int tb = 0; tb < 4; ++tb) {
            const int t = 32 * tb + col; float tot = 0.f;
#pragma unroll
            for (int gg = 0; gg < 8; ++gg) tot += ssqL[gg * 128 + t];
            const float rinv = __builtin_amdgcn_rsqf(tot * (1.0f / 512.0f) + EPS);
#pragma unroll
            for (int db = 0; db < 2; ++db)
#pragma unroll
                for (int a = 0; a < 4; ++a) { const int d0 = 32 * db + 8 * a + 4 * hi; const unsigned w0 = opk[tb][db][2 * a], w1 = opk[tb][db][2 * a + 1];
                    u32x2 w; w.x = pk2(bflo(w0) * rinv, bfhi(w0) * rinv); w.y = pk2(bflo(w1) * rinv, bfhi(w1) * rinv);
                    *(u32x2*)(MX + (row0 + t) * 1024 + 512 + g * 64 + d0) = w; }
        }
    }
    __syncthreads();
}

DI void cmp2_phase(Frame& F) {
    const int gw = F.vcu * NWAVES + F.wave, NGW = F.G * NWAVES, lane = lane_id();
    const float* TC = (const float*)(F.ws + WS_TCMP); const float* c1 = (const float*)(F.ws + WS_C1);
    const float* in4 = fin(F, 4); const float* in8 = fin(F, 8); const float* in9 = fin(F, 9);
    for (int id = gw; id < 4096; id += NGW) {
        const int ti = id >> 11, seg = id & 2047, c = seg & 511;
        bf16* dst = (bf16*)(F.ws + (ti ? WS_VCC : WS_KCN)) + (size_t)seg * 64;
        if (c == 511) { dst[lane] = 0; continue; }
        const float* Tt = TC + (size_t)ti * 2048 * 256;
        const float h0 = gelu_tanh(Tt[(size_t)seg * 256 + lane] + Tt[(size_t)(seg + 1) * 256 + 128 + lane] + c1[ti * 128 + lane]);
        const float h1 = gelu_tanh(Tt[(size_t)seg * 256 + 64 + lane] + Tt[(size_t)(seg + 1) * 256 + 192 + lane] + c1[ti * 128 + 64 + lane]);
        const float* w2 = in8 + (size_t)ti * 128 * 64;
        float o = in9[ti * 64 + lane];
#pragma unroll
        for (int k = 0; k < 64; ++k) o += __int_as_float(__builtin_amdgcn_readlane(__float_as_int(h0), k)) * w2[k * 64 + lane];
#pragma unroll
        for (int k = 0; k < 64; ++k) o += __int_as_float(__builtin_amdgcn_readlane(__float_as_int(h1), k)) * w2[(64 + k) * 64 + lane];
        if (ti == 0) { const float ss = wave_sum(o * o); o = o * __builtin_amdgcn_rsqf(ss * (1.0f / 64.0f) + EPS) * in4[lane]; }
        dst[lane] = (bf16)(pk2(o, 0.f) & 0xffffu);
    }
}

struct AttnP { const bf16 *Q, *KCN, *VCC, *KS, *VS, *KW, *VW; const float* GATES; bf16* MX; };
constexpr int AL_K = 0, AL_V = 24576, AL_WAVE = 57344  , AL_WSTRIDE = 12288, AL_XCH = 155648;
#define GLDS16(src, dst) __builtin_amdgcn_global_load_lds((const unsigned*)(src), (LAS unsigned*)(dst), 16, 0, 0)
DI void dma_k(const bf16* Kt, LAS char* kbuf, int w, int lane) {
    const char* base = (const char*)Kt; asm volatile("" : "+s"(base));
    GLDS16(base + (unsigned)(lane * 128 + w * 16), kbuf + w * 1024);
}
DI void dma_v(const bf16* Vt, LAS char* vbuf, int w, int lane) {
    const char* base = (const char*)Vt; asm volatile("" : "+s"(base));
    GLDS16(base + (unsigned)((16 * (w & 3) + (lane >> 2)) * 128 + (w >> 2) * 64 + (lane & 3) * 16), vbuf + (w >> 2) * 4096 + (w & 3) * 1024);
}
#define TILE_SYNC(more, per) do { if (DBG == 10) asm volatile("s_waitcnt lgkmcnt(0)" ::: "memory"); else if (more) { if ((per) == 2) asm volatile("s_waitcnt vmcnt(2) lgkmcnt(0)" ::: "memory"); else asm volatile("s_waitcnt vmcnt(1) lgkmcnt(0)" ::: "memory"); } \
    else asm volatile("s_waitcnt vmcnt(0) lgkmcnt(0)" ::: "memory"); if (DBG != 9) __builtin_amdgcn_s_barrier(); asm volatile("" ::: "memory"); } while (0)
#define SEQ_SYNC() do { asm volatile("s_waitcnt vmcnt(0) lgkmcnt(0)" ::: "memory"); __builtin_amdgcn_s_barrier(); asm volatile("" ::: "memory"); } while (0)
DI int crf(int r) { return (r & 3) + 8 * (r >> 2); }
DI float sum_x8(float v) { return v + __int_as_float(__builtin_amdgcn_update_dpp(0, __float_as_int(v), 0x128, 0xf, 0xf, false)); }
DI float sum_x16(float v) { const auto r = __builtin_amdgcn_permlane16_swap(__float_as_uint(v), __float_as_uint(v), false, false); return __uint_as_float(r[0]) + __uint_as_float(r[1]); }
DI float sum_x32(float v) { const auto r = __builtin_amdgcn_permlane32_swap(__float_as_uint(v), __float_as_uint(v), false, false); return __uint_as_float(r[0]) + __uint_as_float(r[1]); }
DI float max_x32(float v) { const auto r = __builtin_amdgcn_permlane32_swap(__float_as_uint(v), __float_as_uint(v), false, false); return fmaxf(__uint_as_float(r[0]), __uint_as_float(r[1])); }
DI void qk_lds(LAS const char* kb, LAS const char* qb, const f32x16& c0, const f32x16& c1, f32x16& p0, f32x16& p1, int col, int hi) {
    const unsigned ka = (unsigned)(__SIZE_TYPE__)(kb + hi * 1024 + col * 16), qa = (unsigned)(__SIZE_TYPE__)qb;
    bf16x8 k0[4], k1[4], qf[4];
#pragma unroll
    for (int d0 = 0; d0 < 4; ++d0) {
        asm volatile("ds_read_b128 %0, %1 offset:%c2" : "=&v"(qf[d0]) : "v"(qa), "i"(d0 * 1024) : "memory");
        asm volatile("ds_read_b128 %0, %1 offset:%c2" : "=&v"(k0[d0]) : "v"(ka), "i"(d0 * 2048) : "memory");
        asm volatile("ds_read_b128 %0, %1 offset:%c2" : "=&v"(k1[d0]) : "v"(ka), "i"(d0 * 2048 + 512) : "memory");
    }
    asm volatile("s_waitcnt lgkmcnt(0)" ::: "memory"); __builtin_amdgcn_sched_barrier(0);
    p0 = MFMA32(k0[0], qf[0], c0); p1 = MFMA32(k1[0], qf[0], c1);
#pragma unroll
    for (int d0 = 1; d0 < 4; ++d0) { p0 = MFMA32(k0[d0], qf[d0], p0); p1 = MFMA32(k1[d0], qf[d0], p1); }
}
DI void pv_tile(LAS const char* vp, const u32x4 (&pw)[4], f32x16& o0, f32x16& o1) {
    const unsigned vb = (unsigned)(__SIZE_TYPE__)vp;
#pragma unroll
    for (int d0 = 0; d0 < 2; ++d0) {
        s16x4 lo[4], hi[4];
#pragma unroll
        for (int ks = 0; ks < 4; ++ks) {
            asm volatile("ds_read_b64_tr_b16 %0, %1 offset:%c2" : "=&v"(lo[ks]) : "v"(vb), "i"(d0 * 4096 + ks * 1024) : "memory");
            asm volatile("ds_read_b64_tr_b16 %0, %1 offset:%c2" : "=&v"(hi[ks]) : "v"(vb), "i"(d0 * 4096 + ks * 1024 + 512) : "memory");
        }
        asm volatile("s_waitcnt lgkmcnt(0)" ::: "memory"); __builtin_amdgcn_sched_barrier(0);
#pragma unroll
        for (int ks = 0; ks < 4; ++ks) {
            const bf16x8 pf = __builtin_bit_cast(bf16x8, pw[ks]);
            if (d0 == 0) o0 = MFMA32(mk8(lo[ks], hi[ks]), pf, o0); else o1 = MFMA32(mk8(lo[ks], hi[ks]), pf, o1);
        }
    }
}
DI float fma_s(float a, float ks, float c) { float d; asm("v_fma_f32 %0, %1, %2, %3" : "=v"(d) : "v"(a), "s"(ks), "v"(c)); return d; }
DI float add_(float a, float b) { float d; asm("v_add_f32 %0, %1, %2" : "=v"(d) : "v"(a), "v"(b)); return d; }
DI void mk_cinit(f32x16& c, float A, float B) {
    c[0] = A;
#pragma unroll
    for (int r = 1; r < 16; ++r) c[r] = fma_s(B, (float)crf(r), A);
}
template <bool WIN, int KS> DI void tile_mask(f32x16& p, int dbase) {
#pragma unroll
    for (int r = 0; r < 16; ++r) { bool ok = dbase >= KS * crf(r); if (WIN) ok = ok && (dbase - KS * crf(r) < 512); p[r] = ok ? p[r] : -INFINITY; }
}
DI float max3_(float a, float b, float c) { float d; asm("v_max3_f32 %0, %1, %2, %3" : "=v"(d) : "v"(a), "v"(b), "v"(c)); return d; }
DI float max2_(float a, float b) { float d; asm("v_max_f32 %0, %1, %2" : "=v"(d) : "v"(a), "v"(b)); return d; }
DI float tile_max(f32x16& p0, f32x16& p1) {
    asm volatile("s_nop 15" : "+v"(p0), "+v"(p1));
    float c[4];
#pragma unroll
    for (int k = 0; k < 4; ++k) {
        float a = max3_(p0[k], p1[k], p0[k + 4]);
        a = max3_(a, p1[k + 4], p0[k + 8]);
        a = max3_(a, p1[k + 8], p0[k + 12]);
        c[k] = max2_(a, p1[k + 12]);
    }
    const float v = max2_(max3_(c[0], c[1], c[2]), c[3]);
    const auto r = __builtin_amdgcn_permlane32_swap(__float_as_uint(v), __float_as_uint(v), false, false);
    return max2_(__uint_as_float(r[0]), __uint_as_float(r[1]));
}
DI void pack_p(const f32x16& p0, const f32x16& p1, u32x4 (&pw)[4]) {
#pragma unroll
    for (int s = 0; s < 2; ++s) {
        pw[s] = (u32x4){pk2(p0[8 * s], p0[8 * s + 1]), pk2(p0[8 * s + 2], p0[8 * s + 3]), pk2(p0[8 * s + 4], p0[8 * s + 5]), pk2(p0[8 * s + 6], p0[8 * s + 7])};
        pw[2 + s] = (u32x4){pk2(p1[8 * s], p1[8 * s + 1]), pk2(p1[8 * s + 2], p1[8 * s + 3]), pk2(p1[8 * s + 4], p1[8 * s + 5]), pk2(p1[8 * s + 6], p1[8 * s + 7])};
    }
}
template <bool WIN, int DBG, bool FIX> DI void online_A(LAS const char* kb, int P0, bool selb, bool need_mask, int t, float sl2, LAS const char* qf,
                                     float& m, float& l, f32x16& o0, f32x16& o1, u32x4 (&pw)[4], int col, int hi) {
    int db0 = t - P0 - 4 * hi; asm volatile("" : "+v"(db0));
    const int db1 = db0 - 32;
    const float ninf = selb ? 0.f : -INFINITY;
    f32x16 p0, p1;
    { f32x16 c0, c1; mk_cinit(c0, -sl2 * (float)db0 - m + ninf, sl2); mk_cinit(c1, -sl2 * (float)db1 - m + ninf, sl2); qk_lds(kb, qf, c0, c1, p0, p1, col, hi); }
    if (need_mask) { tile_mask<WIN, 1>(p0, db0); tile_mask<WIN, 1>(p1, db1); }
    const float mt = FIX ? 0.f : tile_max(p0, p1);
    if (!FIX && __any(mt > 8.0f)) {
        const float dl = fmaxf(mt, 0.f), alpha = __builtin_amdgcn_exp2f(-dl);
        m += dl; l *= alpha;
#pragma unroll
        for (int r = 0; r < 16; ++r) { p0[r] -= dl; p1[r] -= dl; o0[r] *= alpha; o1[r] *= alpha; }
    }
    float rs0 = 0.f, rs1 = 0.f, rs2 = 0.f, rs3 = 0.f;
#pragma unroll
    for (int r = 0; r < 16; ++r) { if (DBG != 7) { p0[r] = __builtin_amdgcn_exp2f(p0[r]); p1[r] = __builtin_amdgcn_exp2f(p1[r]); } }
    __builtin_amdgcn_sched_barrier(0);
    rs0 = add_(p0[0], p1[0]); rs1 = add_(p0[1], p1[1]); rs2 = add_(p0[2], p1[2]); rs3 = add_(p0[3], p1[3]);
#pragma unroll
    for (int r = 4; r < 16; r += 4) { rs0 = add_(add_(rs0, p0[r]), p1[r]); rs1 = add_(add_(rs1, p0[r + 1]), p1[r + 1]); rs2 = add_(add_(rs2, p0[r + 2]), p1[r + 2]); rs3 = add_(add_(rs3, p0[r + 3]), p1[r + 3]); }
    l += sum_x32(add_(add_(rs0, rs1), add_(rs2, rs3)));
    pack_p(p0, p1, pw);
}
DI int prev_bit(unsigned long long lo, unsigned long long hi, int n) {
    if (n > 64) { const unsigned long long h = (n >= 128) ? hi : (hi & ((1ull << (n - 64)) - 1ull)); if (h) return 127 - __builtin_clzll(h); n = 64; }
    const unsigned long long l = (n >= 64) ? lo : (lo & ((1ull << n) - 1ull));
    return l ? 63 - __builtin_clzll(l) : -1;
}
template <int DBG, bool FIX> DI void attn_group(const AttnP& P, LAS char* lds, const int g, const int b, const int j, const int w, const int lane_, f32x16& ot0, f32x16& ot1, const int dbg, const int dtok, const float mref) {
    int lane = lane_; asm volatile("" : "+v"(lane));
    const int col = lane & 31, hi = lane >> 5, hh = col >> 3, tok = col & 7, t0 = 64 * j + 8 * w, t = t0 + tok, h = 4 * g + hh;
    const size_t row = (size_t)b * T + t;
    const float sl2 = __builtin_amdgcn_exp2f(-(float)(h + 1)) * LOG2E;
    const float gt0 = P.GATES[row * 24 + h * 3], gt1 = P.GATES[row * 24 + h * 3 + 1], gt2 = P.GATES[row * 24 + h * 3 + 2];
    const size_t hb = (size_t)(b * 2 + g);
    const bf16* Kc = P.KCN + hb * 512 * 64; const bf16* Vc = P.VCC + hb * 512 * 64;
    const bf16* Ks = P.KS + hb * T * 64; const bf16* Vs = P.VS + hb * T * 64; const bf16* Kw = P.KW + hb * T * 64; const bf16* Vw = P.VW + hb * T * 64;
    LAS char* wl = lds + AL_WAVE + w * AL_WSTRIDE; LAS float* imp = (LAS float*)wl;
    LAS const char* qf = wl + 8192 + lane * 16;
#pragma unroll
    for (int d0 = 0; d0 < 4; ++d0) *(LAS bf16x8*)(wl + 8192 + d0 * 1024 + lane * 16) = *(const bf16x8*)(P.Q + row * 512 + h * 64 + 16 * d0 + 8 * hi);
    const int vlane = ((lane >> 4) & 1) * 32 + (lane & 3) * 8 + (4 * hi + ((lane & 15) >> 2)) * 64;
#pragma unroll
    for (int i = 0; i < 4; ++i) ((LAS u32x4*)wl)[i * 64 + lane] = (u32x4){0u, 0u, 0u, 0u};
    const int ncv = ((64 * j + 63 - 31) >> 4) + 1, ntc = (DBG == 6) ? 0 : (ncv + 63) >> 6;
    float m = FIX ? mref : -1e30f, l = 0.f;
    int i0 = 0, n_neg = -1;
    if (dtok > 0) { const int c_neg = (64 * j - 31 - dtok) >> 4; if (c_neg >= 63) i0 = ((c_neg - 63) >> 6) + 1; if (i0 > ntc - 1) i0 = ntc > 0 ? ntc - 1 : 0; n_neg = (64 * j - 63 - dtok) >> 6; }
    SEQ_SYNC();
    if (i0 < ntc) dma_k(Kc + i0 * 4096, lds + AL_K, w, lane);
    if (i0 + 1 < ntc) dma_k(Kc + (i0 + 1) * 4096, lds + AL_K + 8192, w, lane);
    for (int i = i0, ib = 0; i < ntc; ++i, ib = (ib == 2 ? 0 : ib + 1)) {
        TILE_SYNC(i + 1 < ntc, 1);
        if (i + 2 < ntc) dma_k(Kc + (i + 2) * 4096, lds + AL_K + (ib == 0 ? 2 : ib - 1) * 8192, w, lane);
        int db0 = t - 31 - 16 * (64 * i + 4 * hi); asm volatile("" : "+v"(db0)); const int db1 = db0 - 512;
        f32x16 p0, p1;
        { const float mr = FIX ? m : 0.f; f32x16 c0, c1; mk_cinit(c0, -sl2 * (float)db0 - mr, sl2 * 16.f); mk_cinit(c1, -sl2 * (float)db1 - mr, sl2 * 16.f); qk_lds(lds + AL_K + ib * 8192, qf, c0, c1, p0, p1, col, hi); }
        if (i + 2 >= ntc) { tile_mask<false, 16>(p0, db0); tile_mask<false, 16>(p1, db1); }
        if (FIX) {
#pragma unroll
            for (int r = 0; r < 16; ++r) { p0[r] = __builtin_amdgcn_exp2f(p0[r]); p1[r] = __builtin_amdgcn_exp2f(p1[r]); }
            __builtin_amdgcn_sched_barrier(0);
            float r0 = add_(p0[0], p1[0]), r1 = add_(p0[1], p1[1]), r2 = add_(p0[2], p1[2]), r3 = add_(p0[3], p1[3]);
#pragma unroll
            for (int r = 4; r < 16; r += 4) { r0 = add_(add_(r0, p0[r]), p1[r]); r1 = add_(add_(r1, p0[r + 1]), p1[r + 1]); r2 = add_(add_(r2, p0[r + 2]), p1[r + 2]); r3 = add_(add_(r3, p0[r + 3]), p1[r + 3]); }
            l += sum_x32(add_(add_(r0, r1), add_(r2, r3)));
        } else {
        const float mt = tile_max(p0, p1), mn = fmaxf(m, mt);
        float rs = 0.f;
#pragma unroll
        for (int r = 0; r < 16; ++r) rs += __builtin_amdgcn_exp2f(p0[r] - mn) + __builtin_amdgcn_exp2f(p1[r] - mn);
        l = l * __builtin_amdgcn_exp2f(m - mn) + sum_x32(rs); m = mn;
        }
    }
    const float lil = l > 0.f ? -__builtin_amdgcn_logf(l) : -INFINITY;
    f32x16 oc0 = {}, oc1 = {};
    SEQ_SYNC();
    if (i0 < ntc) { dma_k(Kc + i0 * 4096, lds + AL_K, w, lane); dma_v(Vc + i0 * 4096, lds + AL_V, w, lane); }
    if (i0 + 1 < ntc) { dma_k(Kc + (i0 + 1) * 4096, lds + AL_K + 8192, w, lane); dma_v(Vc + (i0 + 1) * 4096, lds + AL_V + 8192, w, lane); }
    {
        u32x4 pw[4];
        int ik = 0, iv = 0;
        for (int i = i0; i < ntc; ++i) {
            TILE_SYNC(i + 1 < ntc, 2);
            if (i + 2 < ntc) { dma_k(Kc + (i + 2) * 4096, lds + AL_K + (ik == 0 ? 2 : ik - 1) * 8192, w, lane); dma_v(Vc + (i + 2) * 4096, lds + AL_V + ((iv + 2) & 3) * 8192, w, lane); }
            int db0 = t - 31 - 16 * (64 * i + 4 * hi); asm volatile("" : "+v"(db0)); const int db1 = db0 - 512;
            f32x16 p0, p1;
            { f32x16 c0, c1; mk_cinit(c0, -sl2 * (float)db0 - m + lil, sl2 * 16.f); mk_cinit(c1, -sl2 * (float)db1 - m + lil, sl2 * 16.f); qk_lds(lds + AL_K + ik * 8192, qf, c0, c1, p0, p1, col, hi); }
            if (i + 2 >= ntc) { tile_mask<false, 16>(p0, db0); tile_mask<false, 16>(p1, db1); }
#pragma unroll
            for (int r = 0; r < 16; ++r) { p0[r] = __builtin_amdgcn_exp2f(p0[r]); p1[r] = __builtin_amdgcn_exp2f(p1[r]); }
            LAS float* impb = imp + (16 * i + hi) * 8 + tok; asm volatile("" : "+v"(impb));
#pragma unroll
            for (int kb = 0; kb < 2; ++kb)
#pragma unroll
                for (int a = 0; a < 4; ++a) { const int r0 = 4 * a;
                    const float x0 = kb ? p1[r0] : p0[r0], x1 = kb ? p1[r0 + 1] : p0[r0 + 1], x2 = kb ? p1[r0 + 2] : p0[r0 + 2], x3 = kb ? p1[r0 + 3] : p0[r0 + 3];
                    float mv = (x0 + x1) + (x2 + 0.5f * x3), sv = 0.5f * x3;
                    mv = sum_x16(sum_x8(mv)); sv = sum_x16(sum_x8(sv));
                    const int n = 16 * i + 8 * kb + 2 * a + hi;
                    if (hh == 0) { asm volatile("ds_add_f32 %0, %1 offset:%c2" :: "v"((unsigned)(__SIZE_TYPE__)impb), "v"(mv), "i"((8 * kb + 2 * a) * 32) : "memory");
                        if (n < 127) asm volatile("ds_add_f32 %0, %1 offset:%c2" :: "v"((unsigned)(__SIZE_TYPE__)impb), "v"(sv), "i"((8 * kb + 2 * a + 1) * 32) : "memory"); } }
            pack_p(p0, p1, pw);
            pv_tile(lds + AL_V + iv * 8192 + vlane, pw, oc0, oc1);
            ik = (ik == 2 ? 0 : ik + 1); iv = (iv + 1) & 3;
        }
    }
    const int nfirst = (DBG == 6) ? j + 1 : (j >= 8 ? j - 8 : 0);
    SEQ_SYNC();
    if (DBG != 6) { dma_k(Kw + (size_t)j * 4096, lds + AL_K, w, lane); dma_v(Vw + (size_t)j * 4096, lds + AL_V, w, lane);
        if (j > nfirst) { dma_k(Kw + (size_t)(j - 1) * 4096, lds + AL_K + 8192, w, lane); dma_v(Vw + (size_t)(j - 1) * 4096, lds + AL_V + 8192, w, lane); } }
    unsigned mwl[4]; unsigned long long ulo, uhi;
    if (j < 16 || DBG == 5 || DBG == 6) {
        mwl[0] = (2u << (j & 15)) - 1u; mwl[1] = 0u; mwl[2] = 0u; mwl[3] = 0u; ulo = (DBG == 6) ? 0ull : (j < 16 ? (2ull << j) - 1ull : 0x3ffffffull); uhi = (DBG == 5 && j >= 64) ? (1ull << (j - 64)) : 0ull; if (DBG == 5 && j >= 16 && j < 64) ulo |= 1ull << j;
    } else {
        const int tk = lane >> 3, sub = lane & 7;
        unsigned keys[16];
#pragma unroll
        for (int i = 0; i < 16; ++i) { const int n = i * 8 + sub; const float v = imp[n * 8 + tk];
            keys[i] = (n < j && n != 0) ? ((__float_as_uint(v) & ~255u) | (unsigned)(255 - n)) : 0u; }
        unsigned mw[4] = {1u, 0u, 0u, 0u};
#pragma unroll
        for (int q = 0; q < 4; ++q) mw[q] |= ((j >> 5) == q) ? (1u << (j & 31)) : 0u;
        for (int round = 0; round < 14; ++round) {
            unsigned mx = keys[0];
#pragma unroll
            for (int i = 1; i < 16; ++i) mx = mx > keys[i] ? mx : keys[i];
            unsigned o;
            o = (unsigned)__builtin_amdgcn_update_dpp(0, (int)mx, 0xB1, 0xf, 0xf, false); mx = mx > o ? mx : o;
            o = (unsigned)__builtin_amdgcn_update_dpp(0, (int)mx, 0x4E, 0xf, 0xf, false); mx = mx > o ? mx : o;
            o = (unsigned)__builtin_amdgcn_update_dpp(0, (int)mx, 0x141, 0xf, 0xf, false); mx = mx > o ? mx : o;
            if (mx != 0u) { const int n = 255 - (int)(mx & 255u);
#pragma unroll
                for (int q = 0; q < 4; ++q) mw[q] |= ((n >> 5) == q) ? (1u << (n & 31)) : 0u;
#pragma unroll
                for (int i = 0; i < 16; ++i) keys[i] = keys[i] == mx ? 0u : keys[i]; }
        }
        LAS unsigned* xch = (LAS unsigned*)(lds + AL_XCH);
#pragma unroll
        for (int q = 0; q < 4; ++q) { mwl[q] = __shfl(mw[q], (lane & 7) * 8);
            unsigned u = mw[q]; u |= __shfl_xor(u, 8); u |= __shfl_xor(u, 16); u |= __shfl_xor(u, 32); if (lane == 0) xch[w * 4 + q] = u; }
        __syncthreads();
        unsigned u = xch[lane & 31]; u |= __shfl_xor(u, 4); u |= __shfl_xor(u, 8); u |= __shfl_xor(u, 16);
        const unsigned u0 = __builtin_amdgcn_readlane(u, 0), u1 = __builtin_amdgcn_readlane(u, 1), u2 = __builtin_amdgcn_readlane(u, 2), u3 = __builtin_amdgcn_readlane(u, 3);
        ulo = ((unsigned long long)u1 << 32) | u0; uhi = ((unsigned long long)u3 << 32) | u2;
    }
    LAS u32x4* acs = (LAS u32x4*)(wl + lane * 64);
#pragma unroll
    for (int a = 0; a < 2; ++a) {
        acs[a] = (u32x4){pk2(oc0[8 * a] * gt0, oc0[8 * a + 1] * gt0), pk2(oc0[8 * a + 2] * gt0, oc0[8 * a + 3] * gt0), pk2(oc0[8 * a + 4] * gt0, oc0[8 * a + 5] * gt0), pk2(oc0[8 * a + 6] * gt0, oc0[8 * a + 7] * gt0)};
        acs[2 + a] = (u32x4){pk2(oc1[8 * a] * gt0, oc1[8 * a + 1] * gt0), pk2(oc1[8 * a + 2] * gt0, oc1[8 * a + 3] * gt0), pk2(oc1[8 * a + 4] * gt0, oc1[8 * a + 5] * gt0), pk2(oc1[8 * a + 6] * gt0, oc1[8 * a + 7] * gt0)};
    }
    {
        float mw_ = FIX ? mref : 0.f, lw = 0.f; f32x16 o0 = {}, o1 = {};
        u32x4 pw[4]; int ik = 0, iv = 0;
        for (int n = j; n >= nfirst; --n) {
            TILE_SYNC(n > nfirst, 2);
            if (n - 2 >= nfirst) { dma_k(Kw + (size_t)(n - 2) * 4096, lds + AL_K + (ik == 0 ? 2 : ik - 1) * 8192, w, lane); dma_v(Vw + (size_t)(n - 2) * 4096, lds + AL_V + ((iv + 2) & 3) * 8192, w, lane); }
            online_A<true, DBG, FIX>(lds + AL_K + ik * 8192, 64 * n, true, (n == j) || (n + 8 <= j), t, sl2, qf, mw_, lw, o0, o1, pw, col, hi);
            if (DBG != 8) pv_tile(lds + AL_V + iv * 8192 + vlane, pw, o0, o1); else { o0[0] += __uint_as_float(pw[0].x); }
            ik = (ik == 2 ? 0 : ik + 1); iv = (iv + 1) & 3;
        }
        const float sc = (DBG == 6) ? 0.f : gt2 / lw;
#pragma unroll
        for (int a = 0; a < 2; ++a) {
            const u32x4 q0 = acs[a], q1 = acs[2 + a];
            acs[a] = (u32x4){pk2(bflo(q0.x) + o0[8 * a] * sc, bfhi(q0.x) + o0[8 * a + 1] * sc), pk2(bflo(q0.y) + o0[8 * a + 2] * sc, bfhi(q0.y) + o0[8 * a + 3] * sc),
                             pk2(bflo(q0.z) + o0[8 * a + 4] * sc, bfhi(q0.z) + o0[8 * a + 5] * sc), pk2(bflo(q0.w) + o0[8 * a + 6] * sc, bfhi(q0.w) + o0[8 * a + 7] * sc)};
            acs[2 + a] = (u32x4){pk2(bflo(q1.x) + o1[8 * a] * sc, bfhi(q1.x) + o1[8 * a + 1] * sc), pk2(bflo(q1.y) + o1[8 * a + 2] * sc, bfhi(q1.y) + o1[8 * a + 3] * sc),
                                 pk2(bflo(q1.z) + o1[8 * a + 4] * sc, bfhi(q1.z) + o1[8 * a + 5] * sc), pk2(bflo(q1.w) + o1[8 * a + 6] * sc, bfhi(q1.w) + o1[8 * a + 7] * sc)};
        }
    }
    {
        float ms = FIX ? mref : 0.f, ls = 0.f; f32x16 o0 = {}, o1 = {};
        if (n_neg >= 0) { if (n_neg >= 63) { ulo = 0ull; if (n_neg >= 64) uhi &= ~((2ull << (n_neg - 64)) - 1ull); } else ulo &= ~((2ull << n_neg) - 1ull); }
        int cur = prev_bit(ulo, uhi, 128), ik = 0, iv = 0;
        int nxt = cur >= 0 ? prev_bit(ulo, uhi, cur) : -1;
        u32x4 pw[4] = {}; bool first = true;
        SEQ_SYNC();
        if (cur >= 0) { dma_k(Ks + (size_t)cur * 4096, lds + AL_K, w, lane); dma_v(Vs + (size_t)cur * 4096, lds + AL_V, w, lane); }
        if (nxt >= 0) { dma_k(Ks + (size_t)nxt * 4096, lds + AL_K + 8192, w, lane); dma_v(Vs + (size_t)nxt * 4096, lds + AL_V + 8192, w, lane); }
        while (cur >= 0) {
            const int nx2 = nxt >= 0 ? prev_bit(ulo, uhi, nxt) : -1;
            TILE_SYNC(nxt >= 0, 2);
            if (nx2 >= 0) { dma_k(Ks + (size_t)nx2 * 4096, lds + AL_K + (ik == 0 ? 2 : ik - 1) * 8192, w, lane); dma_v(Vs + (size_t)nx2 * 4096, lds + AL_V + ((iv + 2) & 3) * 8192, w, lane); }
            const unsigned lword = (cur < 32) ? mwl[0] : (cur < 64) ? mwl[1] : (cur < 96) ? mwl[2] : mwl[3];
            const bool selb = (lword >> (cur & 31)) & 1u;
            online_A<false, DBG, FIX>(lds + AL_K + ik * 8192, 64 * cur, selb, cur == j, t, sl2, qf, ms, ls, o0, o1, pw, col, hi);
            if (DBG != 8) pv_tile(lds + AL_V + iv * 8192 + vlane, pw, o0, o1); else { o0[0] += __uint_as_float(pw[0].x); }
            cur = nxt; nxt = nx2; ik = (ik == 2 ? 0 : ik + 1); iv = (iv + 1) & 3; first = false;
        }
        const float sc = (DBG == 6) ? 0.f : gt1 / ls;
#pragma unroll
        for (int a = 0; a < 2; ++a) {
            const u32x4 q0 = acs[a], q1 = acs[2 + a];
            ot0[8 * a] = bflo(q0.x) + o0[8 * a] * sc; ot0[8 * a + 1] = bfhi(q0.x) + o0[8 * a + 1] * sc; ot0[8 * a + 2] = bflo(q0.y) + o0[8 * a + 2] * sc; ot0[8 * a + 3] = bfhi(q0.y) + o0[8 * a + 3] * sc;
            ot0[8 * a + 4] = bflo(q0.z) + o0[8 * a + 4] * sc; ot0[8 * a + 5] = bfhi(q0.z) + o0[8 * a + 5] * sc; ot0[8 * a + 6] = bflo(q0.w) + o0[8 * a + 6] * sc; ot0[8 * a + 7] = bfhi(q0.w) + o0[8 * a + 7] * sc;
            ot1[8 * a] = bflo(q1.x) + o1[8 * a] * sc; ot1[8 * a + 1] = bfhi(q1.x) + o1[8 * a + 1] * sc; ot1[8 * a + 2] = bflo(q1.y) + o1[8 * a + 2] * sc; ot1[8 * a + 3] = bfhi(q1.y) + o1[8 * a + 3] * sc;
            ot1[8 * a + 4] = bflo(q1.z) + o1[8 * a + 4] * sc; ot1[8 * a + 5] = bfhi(q1.z) + o1[8 * a + 5] * sc; ot1[8 * a + 6] = bflo(q1.w) + o1[8 * a + 6] * sc; ot1[8 * a + 7] = bfhi(q1.w) + o1[8 * a + 7] * sc;
        }
    }
}
template <int DBG> DI void attn_phase(Frame& F, const int dbg) {
    AttnP P; P.Q = (const bf16*)(F.ws + WS_Q); P.KCN = (const bf16*)(F.ws + WS_KCN); P.VCC = (const bf16*)(F.ws + WS_VCC);
    P.KS = (const bf16*)(F.ws + WS_KS); P.VS = (const bf16*)(F.ws + WS_VS); P.KW = (const bf16*)(F.ws + WS_KW); P.VW = (const bf16*)(F.ws + WS_VW);
    P.GATES = (const float*)(F.ws + WS_GATES); P.MX = (bf16*)(F.ws + ((dbg || DBG >= 5) ? WS_O2 : WS_MIXED));
    const int lane = lane_id(), w = F.wave;
    LAS char* lds = (LAS char*)F.lds;
    int dtok0; float mref;
    { const float* qg = fin(F, 3); const float* kg = fin(F, 4);
      float a = fabsf(qg[lane]), c = fmaxf(fabsf(kg[lane]), fabsf(kg[64 + lane]));
#pragma unroll
      for (int o = 1; o < 64; o <<= 1) { a = fmaxf(a, __shfl_xor(a, o)); c = fmaxf(c, __shfl_xor(c, o)); }
      const float Bq = 8.0f * LOG2E * a * c;
      dtok0 = __builtin_amdgcn_readfirstlane((int)((2.0f * Bq + 39.0f) / (0.0625f * LOG2E)) + 1);
      float c3 = fmaxf(c, fabsf(kg[128 + lane]));
#pragma unroll
      for (int o = 1; o < 64; o <<= 1) c3 = fmaxf(c3, __shfl_xor(c3, o));
      mref = __uint_as_float(__builtin_amdgcn_readfirstlane(__float_as_uint(8.0f * LOG2E * a * c3 * 1.02f + 1.0f))); }
    const bool fixref = mref <= 40.0f;
    for (int u = F.vcu; u < M / 64; u += F.G) {
        const int b = u >> 7, j = u & 127;
        const int col = lane & 31, hi = lane >> 5, hh = col >> 3, tok = col & 7;
        LAS u32x4* st = (LAS u32x4*)(lds + AL_WAVE + w * AL_WSTRIDE + 4096 + lane * 64);
        float ssq = 0.f;
        {
            f32x16 oa0, oa1;
            if (fixref) attn_group<DBG, true>(P, lds, 0, b, j, w, lane, oa0, oa1, dbg, dtok0, mref); else attn_group<DBG, false>(P, lds, 0, b, j, w, lane, oa0, oa1, dbg, dtok0, 0.f);
#pragma unroll
            for (int r = 0; r < 16; ++r) ssq += oa0[r] * oa0[r] + oa1[r] * oa1[r];
#pragma unroll
            for (int a = 0; a < 2; ++a) {
                st[a] = (u32x4){pk2(oa0[8 * a], oa0[8 * a + 1]), pk2(oa0[8 * a + 2], oa0[8 * a + 3]), pk2(oa0[8 * a + 4], oa0[8 * a + 5]), pk2(oa0[8 * a + 6], oa0[8 * a + 7])};
                st[2 + a] = (u32x4){pk2(oa1[8 * a], oa1[8 * a + 1]), pk2(oa1[8 * a + 2], oa1[8 * a + 3]), pk2(oa1[8 * a + 4], oa1[8 * a + 5]), pk2(oa1[8 * a + 6], oa1[8 * a + 7])};
            }
        }
        f32x16 ob0, ob1;
        if (fixref) attn_group<DBG, true>(P, lds, 1, b, j, w, lane, ob0, ob1, dbg, 0, mref); else attn_group<DBG, false>(P, lds, 1, b, j, w, lane, ob0, ob1, dbg, 0, 0.f);
#pragma unroll
        for (int r = 0; r < 16; ++r) ssq += ob0[r] * ob0[r] + ob1[r] * ob1[r];
        ssq += __shfl_xor(ssq, 32); ssq += __shfl_xor(ssq, 8); ssq += __shfl_xor(ssq, 16);
        const float rinv = __builtin_amdgcn_rsqf(ssq * (1.0f / 512.0f) + EPS);
        bf16* mp = P.MX + ((size_t)b * T + 64 * j + 8 * w + tok) * 1024 + hh * 64 + 4 * hi;
#pragma unroll
        for (int a = 0; a < 2; ++a) {
            const u32x4 q0 = st[a], q1 = st[2 + a];
            u32x2 wv;
            wv.x = pk2(bflo(q0.x) * rinv, bfhi(q0.x) * rinv); wv.y = pk2(bflo(q0.y) * rinv, bfhi(q0.y) * rinv); *(u32x2*)(mp + 8 * (2 * a)) = wv;
            wv.x = pk2(bflo(q0.z) * rinv, bfhi(q0.z) * rinv); wv.y = pk2(bflo(q0.w) * rinv, bfhi(q0.w) * rinv); *(u32x2*)(mp + 8 * (2 * a + 1)) = wv;
            wv.x = pk2(bflo(q1.x) * rinv, bfhi(q1.x) * rinv); wv.y = pk2(bflo(q1.y) * rinv, bfhi(q1.y) * rinv); *(u32x2*)(mp + 32 + 8 * (2 * a)) = wv;
            wv.x = pk2(bflo(q1.z) * rinv, bfhi(q1.z) * rinv); wv.y = pk2(bflo(q1.w) * rinv, bfhi(q1.w) * rinv); *(u32x2*)(mp + 32 + 8 * (2 * a + 1)) = wv;
        }
#pragma unroll
        for (int a = 0; a < 4; ++a) {
            u32x2 wv;
            wv.x = pk2(ob0[4 * a] * rinv, ob0[4 * a + 1] * rinv); wv.y = pk2(ob0[4 * a + 2] * rinv, ob0[4 * a + 3] * rinv); *(u32x2*)(mp + 256 + 8 * a) = wv;
            wv.x = pk2(ob1[4 * a] * rinv, ob1[4 * a + 1] * rinv); wv.y = pk2(ob1[4 * a + 2] * rinv, ob1[4 * a + 3] * rinv); *(u32x2*)(mp + 256 + 32 + 8 * a) = wv;
        }
    }
    __syncthreads();
}
DI void attn_tail_convert(Frame& F) {
    LAS char* tile = (LAS char*)F.lds + AL_WAVE + F.wave * AL_WSTRIDE;
    if (F.G == 256) { const int b = F.vcu >> 7, j = F.vcu & 127; if (j < 27) p0_convert(F, tile, CV_A3, CV_A3 + CV_N4, (b * 27 + j) * NWAVES + F.wave, 54 * NWAVES); }
    else p0_convert(F, tile, CV_A3, CV_A3 + CV_N4, F.vcu * NWAVES + F.wave, F.G * NWAVES);
}

DI float xch1(float v)  { return __int_as_float(__builtin_amdgcn_update_dpp(0, __float_as_int(v), 0xB1, 0xf, 0xf, false)); }
DI float xch2(float v)  { return __int_as_float(__builtin_amdgcn_update_dpp(0, __float_as_int(v), 0x4E, 0xf, 0xf, false)); }
DI float xch4(float v)  { const int t = __builtin_amdgcn_update_dpp(0, __float_as_int(v), 0x141, 0xf, 0xf, false); return __int_as_float(__builtin_amdgcn_update_dpp(0, t, 0x1B, 0xf, 0xf, false)); }
DI float xch8(float v)  { return __int_as_float(__builtin_amdgcn_update_dpp(0, __float_as_int(v), 0x128, 0xf, 0xf, false)); }
DI float xch16(float v, int lane) { const auto r = __builtin_amdgcn_permlane16_swap(__float_as_uint(v), __float_as_uint(v), false, false); return __uint_as_float((lane & 16) ? r[0] : r[1]); }
DI float xch32(float v, int lane) { const auto r = __builtin_amdgcn_permlane32_swap(__float_as_uint(v), __float_as_uint(v), false, false); return __uint_as_float((lane & 32) ? r[0] : r[1]); }
constexpr int RT_WH = 0, RT_WL = 65536, RT_PART = 131072  , RT_AUX = 156672, RT_SSQ = RT_AUX + 2560;
static_assert(RT_PART + 3 * 64 * 33 * 4 <= RT_AUX && RT_SSQ + 1024 <= MISC_OFF, "router LDS map");
template <int DBG> DI void route_phase(Frame& F) {
    const int lane = lane_id(), w = F.wave, tid = w * 64 + lane, col = lane & 31, hi = lane >> 5, ct = w & 1, kq = w >> 1;
    LAS char* lds = (LAS char*)F.lds;
    LAS int* hist = (LAS int*)(lds + RT_AUX); LAS int* base = hist + 32; LAS int* tmp = hist + 64; LAS float* tmpg = (LAS float*)(hist + 64 + 256); LAS float* tmpr = (LAS float*)(hist + 64 + 512);
    LAS float* part = (LAS float*)(lds + RT_PART); LAS float* ssqp = (LAS float*)(lds + RT_SSQ);
    const float* wr = fin(F, 17); const float* g2 = fin(F, 16); const float* br = fin(F, 18);
    for (int it = tid; it < 64 * 64; it += NWAVES * 64) {
        const int ks = it >> 6, ln = it & 63, e = ln & 31, k0 = 16 * ks + 8 * (ln >> 5);
        float v[8];
#pragma unroll
        for (int j = 0; j < 8; ++j) v[j] = wr[(k0 + j) * 32 + e] * g2[k0 + j];
        u32x4 h, lo;
        h.x = pk2(v[0], v[1]); h.y = pk2(v[2], v[3]); h.z = pk2(v[4], v[5]); h.w = pk2(v[6], v[7]);
        lo.x = pk2(v[0] - bflo(h.x), v[1] - bfhi(h.x)); lo.y = pk2(v[2] - bflo(h.y), v[3] - bfhi(h.y)); lo.z = pk2(v[4] - bflo(h.z), v[5] - bfhi(h.z)); lo.w = pk2(v[6] - bflo(h.w), v[7] - bfhi(h.w));
        *(LAS u32x4*)(lds + RT_WH + it * 16) = h; *(LAS u32x4*)(lds + RT_WL + it * 16) = lo;
    }
    int* list = (int*)(F.ws + WS_LIST); int* tokinfo = (int*)(F.ws + WS_TOKINFO); float* tgate = (float*)(F.ws + WS_TGATE);
    for (int blk = F.vcu; blk < M / 64; blk += F.G) {
        if (tid < 32) hist[tid] = 0;
        __syncthreads();
        const int tok = blk * 64 + 32 * ct + col;
        const bf16* xr = (const bf16*)(F.ws + WS_X1H) + (size_t)tok * D + 256 * kq + 8 * hi;
        f32x16 acc = {};
        float ssq = 0.f;
#pragma unroll 4
        for (int ks = 0; ks < 16; ++ks) {
            const u32x4 xq = *(const u32x4*)(xr + 16 * ks);
            { const float a0 = bflo(xq.x), a1 = bfhi(xq.x), a2 = bflo(xq.y), a3 = bfhi(xq.y), a4 = bflo(xq.z), a5 = bfhi(xq.z), a6 = bflo(xq.w), a7 = bfhi(xq.w);
              ssq += (a0 * a0 + a1 * a1) + (a2 * a2 + a3 * a3) + (a4 * a4 + a5 * a5) + (a6 * a6 + a7 * a7); }
            const int fo = ((16 * kq + ks) * 64 + lane) * 16;
            const bf16x8 wh = *(const LAS bf16x8*)(lds + RT_WH + fo), wl = *(const LAS bf16x8*)(lds + RT_WL + fo);
            const bf16x8 bx = __builtin_bit_cast(bf16x8, xq);
            acc = MFMA32(wh, bx, acc); acc = MFMA32(wl, bx, acc);
        }
        ssq += xch32(ssq, lane);
        if (hi == 0) ssqp[kq * 64 + 32 * ct + col] = ssq;
        if (kq > 0) {
#pragma unroll
            for (int r = 0; r < 16; ++r) part[((kq - 1) * 64 + 32 * ct + col) * 33 + (r & 3) + 8 * (r >> 2) + 4 * hi] = acc[r];
        }
        __syncthreads();
        if (kq == 0) {
            const int tl = 32 * ct + col;
            const float rinv = __builtin_amdgcn_rsqf((ssqp[tl] + ssqp[64 + tl] + ssqp[128 + tl] + ssqp[192 + tl]) * (1.f / D) + EPS);
            unsigned keys[16]; float lg[16];
#pragma unroll
            for (int r = 0; r < 16; ++r) { const int e = (r & 3) + 8 * (r >> 2) + 4 * hi;
                const float s = acc[r] + part[tl * 33 + e] + part[(64 + tl) * 33 + e] + part[(128 + tl) * 33 + e];
                lg[r] = s * rinv + br[e];
                unsigned ub = __float_as_uint(lg[r]); ub = (ub & 0x80000000u) ? ~ub : (ub | 0x80000000u);
                keys[r] = (ub & ~31u) | (unsigned)(31 - e); }
            int ek[4]; float vk[4];
#pragma unroll
            for (int k = 0; k < 4; ++k) {
                unsigned mx = keys[0];
#pragma unroll
                for (int r = 1; r < 16; ++r) mx = mx > keys[r] ? mx : keys[r];
                const unsigned o = __float_as_uint(xch32(__uint_as_float(mx), lane)); mx = mx > o ? mx : o;
                ek[k] = 31 - (int)(mx & 31u);
                float v = 0.f;
#pragma unroll
                for (int r = 0; r < 16; ++r) { if (keys[r] == mx) { v = lg[r]; keys[r] = 0u; } }
                v += xch32(v, lane);
                vk[k] = v;
            }
            const float e1 = __expf(vk[1] - vk[0]), e2 = __expf(vk[2] - vk[0]), e3 = __expf(vk[3] - vk[0]);
            const float inv = 1.0f / (1.0f + e1 + e2 + e3);
            if (hi == 0) {
#pragma unroll
                for (int k = 0; k < 4; ++k) {
                    const float gg = (k == 0 ? 1.0f : k == 1 ? e1 : k == 2 ? e2 : e3) * inv;
                    const int rank = __hip_atomic_fetch_add(&hist[ek[k]], 1, __ATOMIC_RELAXED, __HIP_MEMORY_SCOPE_WORKGROUP);
                    tmp[tl * 4 + k] = (ek[k] << 16) | rank; tmpg[tl * 4 + k] = gg;
                }
                tmpr[tl] = rinv;
            }
        }
        __syncthreads();
        if (tid < 32) base[tid] = DBG ? 0 : (int)__hip_atomic_fetch_add((unsigned*)(F.ctl + CW_CNT + tid), (unsigned)hist[tid], __ATOMIC_RELAXED, __HIP_MEMORY_SCOPE_AGENT);
        __syncthreads();
        if (tid < 256 && !DBG) {
            const int rowi = tid >> 2, k = tid & 3, pk = tmp[tid], ee = pk >> 16, p = base[ee] + (pk & 0xffff), tk = blk * 64 + rowi;
            list[((size_t)ee * M + p) * 2] = tk; list[((size_t)ee * M + p) * 2 + 1] = __float_as_int(tmpr[rowi]);
            tokinfo[tk * 4 + k] = (ee << 16) | p; tgate[tk * 4 + k] = tmpg[tid];
        }
        __syncthreads();
    }
}
DI void moe_tables(Frame& F, LAS int*& tstart, LAS int*& ecnt) {
    const int tid = F.wave * 64 + lane_id();
    tstart = (LAS int*)(F.lds + AUX_OFF + 8192); ecnt = tstart + 64;
    if (tid == 0) { int a = 0; for (int e = 0; e < 32; ++e) { const int c = (int)__hip_atomic_load((unsigned*)(F.ctl + CW_CNT + e), __ATOMIC_RELAXED, __HIP_MEMORY_SCOPE_AGENT); tstart[e] = a; ecnt[e] = c; a += (c + 255) >> 8; } tstart[32] = a; }
    __syncthreads();
}
template <int DBG> DI void final_phase(Frame& F, const LAS int* tstart) {
    const int gw = F.vcu * NWAVES + F.wave, NGW = F.G * NWAVES, lane = lane_id();
    const int* tokinfo = (const int*)(F.ws + WS_TOKINFO); const float* tgate = (const float*)(F.ws + WS_TGATE); const unsigned char* O2 = F.ws + WS_O2;
    for (int tok = gw; tok < M; tok += NGW) {
        f32x4* op = (f32x4*)(F.out + (size_t)tok * D) + lane;
        const u32x2* xp = (const u32x2*)(F.ws + WS_X1H + (size_t)tok * D * 2) + lane;
        f32x4 a[4];
#pragma unroll
        for (int j = 0; j < 4; ++j) { const u32x2 h = __builtin_nontemporal_load(xp + 64 * j); a[j].x = bflo(h.x); a[j].y = bfhi(h.x); a[j].z = bflo(h.y); a[j].w = bfhi(h.y); }
#pragma unroll
        for (int k = 0; k < 4; ++k) {
            const int info = tokinfo[tok * 4 + k]; const float gk = tgate[tok * 4 + k] * O2SCALE_INV;
            const size_t rowk = (size_t)tstart[info >> 16] * 256 + (info & 0xffff);
            const unsigned* o2 = (const unsigned*)(O2 + rowk * 1024) + lane;
#pragma unroll
            for (int j = 0; j < 4; ++j) { const unsigned w = __builtin_nontemporal_load(o2 + 64 * j);
                a[j].x += gk * __builtin_amdgcn_cvt_f32_fp8(w, 0); a[j].y += gk * __builtin_amdgcn_cvt_f32_fp8(w, 1); a[j].z += gk * __builtin_amdgcn_cvt_f32_fp8(w, 2); a[j].w += gk * __builtin_amdgcn_cvt_f32_fp8(w, 3); }
        }
        f32x4* wp = DBG ? (f32x4*)((float*)(F.ws + WS_H) + (size_t)(tok & 8191) * D) + lane : op;
#pragma unroll
        for (int j = 0; j < 4; ++j) __builtin_nontemporal_store(a[j], wp + 64 * j);
    }
}

#ifndef MK_SPLIT
#define MK_SPLIT 0
#endif
constexpr int NPHASE = 10;
struct Args { const float* in[23]; float* out; unsigned char* ws; int ph_lo, ph_hi, dbg, pad; };
template <int DBG> __global__ void __launch_bounds__(NWAVES * 64, 2) mk_fwd_t(Args args) {
    extern __shared__ __attribute__((aligned(16))) unsigned char lds[];
    Frame F;
    F.lds = (LAS unsigned char*)lds; F.MISC = (volatile LAS unsigned*)(F.lds + MISC_OFF);
    F.wave = __builtin_amdgcn_readfirstlane((int)threadIdx.x >> 6);
    F.G = gridDim.x; { const int bx = blockIdx.x; F.vcu = (F.G % 8 == 0) ? (bx % 8) * (F.G / 8) + bx / 8 : bx; }
    F.ka = (kptr_t)__builtin_amdgcn_kernarg_segment_ptr();
    F.out = args.out; F.ws = args.ws; F.ctl = (gu32*)(args.ws + WS_CTL);
    unsigned char* ws = args.ws;
    { const int tid0 = threadIdx.x; if (tid0 < 128) ((LAS unsigned*)(F.lds + MISC_OFF))[tid0] = 0u; }
    __syncthreads();
    XcdBarrier bar; bar.bar = (unsigned*)(F.ctl + CW_BAR); bar.x = 0; bar.st = nullptr;
    if (!MK_SPLIT) bar = xcd_barrier_post((unsigned*)(F.ctl + CW_BAR), F.MISC + 8, F.wave == 0 && lane_id() == 0);
    const int lo = args.ph_lo, hi = args.ph_hi;
#ifndef ONLY_PHASE
#define ONLY_PHASE -1
#endif
#ifndef MK_ATT_DBG
#define MK_ATT_DBG 0
#endif
#ifndef MK_REP_PHASE
#define MK_REP_PHASE -1
#endif
#define IN(k) ((ONLY_PHASE < 0 || ONLY_PHASE == (k)) && lo <= (k) && (k) < hi)
#ifndef MK_TS
#define MK_TS -1
#endif
    unsigned long long ts0 = 0, ts1 = 0;
#define SEAM(k) do { if (IN(k) && IN((k) + 1)) xcd_barrier(bar, F.wave == 0 && lane_id() == 0); if (MK_TS == (k) + 1) ts0 = __builtin_amdgcn_s_memrealtime(); if (MK_TS == (k)) ts1 = __builtin_amdgcn_s_memrealtime(); } while (0)
    if (MK_TS == 0) ts0 = __builtin_amdgcn_s_memrealtime();

#ifdef MK_XBAR
    if (lo == 0 && hi == NPHASE) for (int xb_ = 0; xb_ < MK_XBAR; ++xb_) xcd_barrier(bar, F.wave == 0 && lane_id() == 0);
#endif
    if (IN(0)) { p0_prologue(F); }
    SEAM(0);
    if (IN(1)) {
        StaticOrder S; S.init(ws + WS_XN, ws + WS_WIN, M, NZP, 2 * D, F.G, (int)blockIdx.x);
        EpiWin E{(bf16*)(ws + WS_Q), (bf16*)(ws + WS_KCH), (bf16*)(ws + WS_VCH), (bf16*)(ws + WS_KS), (bf16*)(ws + WS_VS), (bf16*)(ws + WS_KW), (bf16*)(ws + WS_VW),
                 (bf16*)(ws + WS_U), (bf16*)(ws + WS_VG), (float*)(ws + WS_GATES), (float*)(ws + WS_VSSQ), fin(F, 3), fin(F, 4), DBG == 4 ? 1 : 0};
        pg8::gemm_phase<EpiWin, StaticOrder, true, false>(F.lds, 2 * D, S, E, F.wave);
        if ((int)blockIdx.x >= 128 && F.G == 256) p0_convert(F, (LAS char*)(F.lds + F.wave * 16384), CV_A0, CV_A1, ((int)blockIdx.x - 128) * NWAVES + F.wave, 128 * NWAVES);
        else if (F.G != 256) p0_convert(F, (LAS char*)(F.lds + F.wave * 16384), CV_A0, CV_A1, F.vcu * NWAVES + F.wave, F.G * NWAVES);
    }
    SEAM(1);
    if (IN(2)) {
        gmlp_phase(F);
        CmpOrder S; S.idx = F.vcu - 128; S.A0 = (const char*)(ws + WS_KCH); S.A1 = (const char*)(ws + WS_VCH); S.B = (const char*)(ws + WS_WCMP);
        EpiCmp E{(float*)(ws + WS_TCMP)};
        pg8::gemm_phase<EpiCmp, CmpOrder, false, false>(F.lds, 2048, S, E, F.wave);
        if (F.vcu >= 144 && F.G == 256) p0_convert(F, (LAS char*)(F.lds + F.wave * 16384), CV_A1, CV_A2, (F.vcu - 144) * NWAVES + F.wave, 112 * NWAVES);
        else if (F.G != 256) p0_convert(F, (LAS char*)(F.lds + F.wave * 16384), CV_A1, CV_A2, F.vcu * NWAVES + F.wave, F.G * NWAVES);
    }
    SEAM(2);
    if (IN(3)) { cmp2_phase(F); p0_convert(F, (LAS char*)(F.lds + F.wave * 16384), CV_A2, CV_A3, F.vcu * NWAVES + F.wave, F.G * NWAVES); }
    SEAM(3);
    if (IN(4)) { attn_phase<DBG>(F, args.dbg); if (!args.dbg && DBG < 5) attn_tail_convert(F); }
    SEAM(4);
    if (IN(5)) {
        StaticOrder S; S.init(ws + WS_MIXED, ws + WS_WOUT, M, D, 2 * D, F.G, (int)blockIdx.x);
        EpiWout E{fin(F, 0), ws + WS_X1H, ws + WS_X1B};
        pg8::gemm_phase<EpiWout, StaticOrder, true, false>(F.lds, 2 * D, S, E, F.wave);
    }
    SEAM(5);
    if (IN(6)) { route_phase<DBG>(F); if (CV_LATE > 0) p0_convert(F, (LAS char*)(F.lds + F.wave * 16384), P0_MOE - CV_LATE, P0_MOE, F.vcu * NWAVES + F.wave, F.G * NWAVES); }
    SEAM(6);
    LAS int* tstart = nullptr; LAS int* ecnt = nullptr;
    if (IN(7)) {
        moe_tables(F, tstart, ecnt);
        MoeOrder<8, true, DBG> S; S.G = F.G; S.c = (int)blockIdx.x; S.utot = tstart[32] * 8; S.tstart = tstart; S.ecnt = ecnt;
        S.A = (const char*)(ws + WS_X1B); S.B = (const char*)(ws + WS_WGU); S.bexp = (size_t)2048 * 1024; S.list = (const int*)(ws + WS_LIST); S.stash = F.lds + AUX_OFF; S.dbg = args.dbg;
        EpiG1T<DBG> E{ws + (DBG ? WS_O2 : WS_H), fin(F, 20), (const int*)(ws + WS_LIST), 0};
        pg8::gemm_phase<EpiG1T<DBG>, MoeOrder<8, true, DBG>, true, true>(F.lds, 1024, S, E, F.wave);
    }
    SEAM(7);
    if (IN(8)) {
        moe_tables(F, tstart, ecnt);
        MoeOrder<4, false> S; S.G = F.G; S.c = (int)blockIdx.x; S.utot = tstart[32] * 4; S.tstart = tstart; S.ecnt = ecnt;
        S.A = (const char*)(ws + WS_H); S.B = (const char*)(ws + WS_WD); S.bexp = (size_t)1024 * 1024; S.list = nullptr; S.stash = nullptr; S.dbg = 0;
        EpiG2 E{ws + WS_O2, fin(F, 22)};
        pg8::gemm_phase<EpiG2, MoeOrder<4, false>, true, true>(F.lds, 1024, S, E, F.wave);
    }
    SEAM(8);
    if (IN(9)) { moe_tables(F, tstart, ecnt); final_phase<DBG>(F, tstart); }
    if (lo == 10) { const float* wsrc = fin(F, 19); const int gw = F.vcu * NWAVES + F.wave, lane = lane_id(); f32x4 accf = {0.f, 0.f, 0.f, 0.f};
        for (size_t i = (size_t)gw * 64 + lane; i < (size_t)32 * 1024 * 2048 / 4; i += (size_t)F.G * NWAVES * 64) accf += *(const f32x4*)(wsrc + i * 4);
        if (accf.x == 1.2345f) F.out[0] = accf.y; }
    if (MK_TS >= 0) { if (MK_TS == 9) ts1 = __builtin_amdgcn_s_memrealtime();
        if (blockIdx.x == 0 && F.wave == 0 && lane_id() == 0) { asm volatile("s_waitcnt vmcnt(0)" ::: "memory"); F.out[0] += (float)(ts1 - ts0); } }
#undef IN
#undef SEAM
}

#define mk_fwd mk_fwd_t<0>
#ifndef MK_KDBG
#define MK_KDBG 0
#endif
extern "C" void kernel_launch(void* const* d_in, const int* in_sizes, int n_in, void* d_out, int out_size, void* d_ws, size_t ws_size, hipStream_t stream) {
    static int grid = 0;
    if (grid == 0) {
        if (n_in != 23 || out_size != M * D || ws_size < WS_END) { fprintf(stderr, "kernel_launch: unexpected shapes (n_in %d out %d ws %zu)\n", n_in, out_size, ws_size); grid = -1; return; }
        int dev = 0, cus = 0, per_cu = 0;
        hipGetDevice(&dev); hipDeviceGetAttribute(&cus, hipDeviceAttributeMultiprocessorCount, dev);
        if (hipFuncSetAttribute((const void*)mk_fwd, hipFuncAttributeMaxDynamicSharedMemorySize, LDS_BYTES) != hipSuccess) { fprintf(stderr, "kernel_launch: hipFuncSetAttribute failed\n"); grid = -1; return; }
        hipOccupancyMaxActiveBlocksPerMultiprocessor(&per_cu, (const void*)mk_fwd, NWAVES * 64, LDS_BYTES);
        (void)hipGetLastError();
        if (per_cu < 1) { fprintf(stderr, "kernel_launch: occupancy query says %d blocks per CU\n", per_cu); grid = -1; return; }
        grid = cus;
    }
    if (grid < 0) return;
    hipMemsetAsync((char*)d_ws + WS_CTL, 0, CTL_ZERO_BYTES, stream);
    Args a{};
    for (int i = 0; i < 23; ++i) a.in[i] = (const float*)d_in[i];
    a.out = (float*)d_out; a.ws = (unsigned char*)d_ws;
#if MK_SPLIT
    for (int p = 0; p < NPHASE; ++p) { a.ph_lo = p; a.ph_hi = p + 1; hipLaunchKernelGGL(mk_fwd, dim3(grid), dim3(NWAVES * 64), LDS_BYTES, stream, a);
        if (p == MK_REP_PHASE) { a.dbg = MK_ATT_DBG;
#ifdef MK_FLUSH
            { Args f = a; f.ph_lo = 10; f.ph_hi = 11; hipLaunchKernelGGL(mk_fwd, dim3(grid), dim3(NWAVES * 64), LDS_BYTES, stream, f); }
#if MK_FLUSH == 2
            a.dbg = 0; continue;
#endif
#endif
            if (MK_KDBG) { hipFuncSetAttribute((const void*)mk_fwd_t<MK_KDBG>, hipFuncAttributeMaxDynamicSharedMemorySize, LDS_BYTES); hipLaunchKernelGGL(mk_fwd_t<MK_KDBG>, dim3(grid), dim3(NWAVES * 64), LDS_BYTES, stream, a); } else hipLaunchKernelGGL(mk_fwd, dim3(grid), dim3(NWAVES * 64), LDS_BYTES, stream, a); a.dbg = 0; } }
#else
    a.ph_lo = 0; a.ph_hi = NPHASE;
    void* kargs[] = {&a};
#ifdef MK_PLAIN
    (void)kargs; hipLaunchKernelGGL(mk_fwd, dim3(grid), dim3(NWAVES * 64), LDS_BYTES, stream, a); hipError_t e = hipPeekAtLastError();
#else
    hipError_t e = hipLaunchCooperativeKernel((const void*)mk_fwd, dim3(grid), dim3(NWAVES * 64), kargs, LDS_BYTES, stream);
#endif
    if (e != hipSuccess) fprintf(stderr, "kernel_launch: cooperative launch failed: %s (grid %d)\n", hipGetErrorString(e), grid);
#endif
}
```

```cpp
#include <hip/hip_runtime.h>
#include <cstdio>
#include <cstdint>

#define LAS __attribute__((address_space(3)))
#define GAS __attribute__((address_space(1)))
typedef unsigned short bf16;
typedef short bf16x8 __attribute__((ext_vector_type(8)));
typedef short s16x4 __attribute__((ext_vector_type(4)));
typedef float f32x4 __attribute__((ext_vector_type(4)));
typedef float f32x2 __attribute__((ext_vector_type(2)));
typedef float f32x16 __attribute__((ext_vector_type(16)));
typedef unsigned u32x4 __attribute__((ext_vector_type(4)));
typedef unsigned u32x2 __attribute__((ext_vector_type(2)));
typedef __bf16 bf16x2_t __attribute__((ext_vector_type(2)));
typedef GAS unsigned gu32;

#define DI __device__ __forceinline__
DI unsigned pk2(float lo, float hi) { f32x2 v = {lo, hi}; bf16x2_t b = __builtin_convertvector(v, bf16x2_t); return __builtin_bit_cast(unsigned, b); }
DI int lane_id() { return (int)__builtin_amdgcn_mbcnt_hi(~0u, __builtin_amdgcn_mbcnt_lo(~0u, 0u)); }
DI unsigned pk4_fp8(float a, float b, float c, float d) { unsigned w = 0; w = __builtin_amdgcn_cvt_pk_fp8_f32(a, b, w, false); w = __builtin_amdgcn_cvt_pk_fp8_f32(c, d, w, true); return w; }
DI float bf2f(unsigned short x) { return __uint_as_float((unsigned)x << 16); }
DI float bflo(unsigned w) { return __uint_as_float(w << 16); }
DI float bfhi(unsigned w) { return __uint_as_float(w & 0xffff0000u); }
DI float wave_sum(float v) {
#pragma unroll
    for (int o = 1; o < 64; o <<= 1) v += __shfl_xor(v, o);
    return v;
}
DI float gelu_tanh(float x) {
    const float u = x * (1.0f + 0.044715f * x * x);
    return x * __builtin_amdgcn_rcpf(1.0f + __builtin_amdgcn_exp2f(-2.3022082f * u));
}
DI float sigmoidf_(float x) { return __builtin_amdgcn_rcpf(1.0f + __builtin_amdgcn_exp2f(-1.44269504f * x)); }

#ifndef MK_NTB
#define MK_NTB 0
#endif
namespace pg8 {
constexpr int BM = 256, BK = 64, HALF = 128, HTB = HALF * BK * 2, STAGE_BYTES = 8 * HTB, NXCD = 8, WGM = 8;
__host__ __device__ __forceinline__ int lds_byte(int r, int c) { const int st = (r >> 4) * 2 + (c >> 5), rr = r & 15, cc = c & 31, ob = rr * 64 + cc * 2; return st * 1024 + (ob ^ (((ob >> 9) & 1) << 5)); }
__host__ __device__ __forceinline__ void stage_rc(int b, int& R, int& C) { const int st = b / 1024, sb = b % 1024, swz = sb ^ (((sb >> 9) & 1) << 5); R = (st >> 1) * 16 + swz / 64; C = (st & 1) * 32 + (swz % 64) / 2; }
__host__ __device__ __forceinline__ int perm32(int rho) { const int n = rho >> 4, i = rho & 15; return 8 * (i >> 2) + 4 * n + (i & 3); }

struct Unit { int pm, pn, e, ml, cnt; };
struct Src { const char* a; const char* b; unsigned ao[2][2]; };

typedef int v8i __attribute__((ext_vector_type(8)));
typedef int v4i __attribute__((ext_vector_type(4)));
__device__ __forceinline__ v8i cat8(bf16x8 a, bf16x8 b) { const v4i x = __builtin_bit_cast(v4i, a), y = __builtin_bit_cast(v4i, b); return __builtin_shufflevector(x, y, 0, 1, 2, 3, 4, 5, 6, 7); }
typedef short s16x16 __attribute__((ext_vector_type(16)));
typedef s16x16 s16x16_a16 __attribute__((aligned(16)));
template <class Epi, class Sched, bool ALIGN_EPI, bool FP8>
__device__ __forceinline__ void gemm_phase(LAS unsigned char* lds, const int KB, const Sched& S, const Epi& E, const int wid) {
    const int lane = lane_id(), tid = wid * 64 + lane, wr = wid >> 2, wc = wid & 3, fr = lane & 15, fq = lane >> 4;
    const int nt = KB / 128;
    unsigned voffB[2];
#pragma unroll
    for (int i = 0; i < 2; ++i) { int R, C; stage_rc(tid * 16 + i * 8192, R, C); const int Rb = Epi::PERM ? ((R & ~31) + perm32(R & 31)) : R;
        voffB[i] = (unsigned)(Rb * KB + C * 2); }
    const size_t kstep = (size_t)(BK * 2);
    const size_t hstep = (size_t)HALF * KB;
    const unsigned ldsw = (unsigned)wid * 1024u;
    const int aoff = FP8 ? lds_byte(wr * 64 + fr, fq * 16) : lds_byte(wr * 64 + fr, fq * 8), boff = FP8 ? lds_byte(wc * 32 + fr, fq * 16) : lds_byte(wc * 32 + fr, fq * 8);
#define PG8_SA(b, h) (((b) * 2 + (h)) * HTB)
#define PG8_SB(b, h) ((4 + (b) * 2 + (h)) * HTB)
#define PG8_GLDS(src, dstoff) __builtin_amdgcn_global_load_lds((const unsigned*)(src), (LAS unsigned*)(lds + (dstoff)), 16, 0, 0)
#define PG8_GLDS_NT(src, dstoff) __builtin_amdgcn_global_load_lds((const unsigned*)(src), (LAS unsigned*)(lds + (dstoff)), 16, 0, 2)
#define PG8_STAGE_B(bufoff, gbase) do { _Pragma("unroll") for (int _i = 0; _i < 2; ++_i) { if constexpr (FP8 && MK_NTB) PG8_GLDS_NT((const char*)(gbase) + voffB[_i], (bufoff) + ldsw + _i * 8192); else PG8_GLDS((const char*)(gbase) + voffB[_i], (bufoff) + ldsw + _i * 8192); } } while (0)
#define PG8_STAGE_A(bufoff, gbase, o0, o1) do { PG8_GLDS((const char*)(gbase) + (o0), (bufoff) + ldsw); PG8_GLDS((const char*)(gbase) + (o1), (bufoff) + ldsw + 8192); } while (0)
#define PG8_LDA(dst, b, h) do { _Pragma("unroll") for (int m = 0; m < 4; ++m) _Pragma("unroll") for (int k = 0; k < 2; ++k) dst[m][k] = *(const LAS bf16x8*)(lds + PG8_SA(b, h) + aoff + m * 2048 + (FP8 ? k * 16 : k * 1024)); } while (0)
#define PG8_LDB(dst, b, h) do { _Pragma("unroll") for (int n = 0; n < 2; ++n) _Pragma("unroll") for (int k = 0; k < 2; ++k) dst[n][k] = *(const LAS bf16x8*)(lds + PG8_SB(b, h) + boff + n * 2048 + (FP8 ? k * 16 : k * 1024)); } while (0)
#define PG8_MMA(ai, bj, At, Bt) do { __builtin_amdgcn_s_setprio(1); _Pragma("unroll") for (int m = 0; m < 4; ++m) _Pragma("unroll") for (int n = 0; n < 2; ++n) { \
        if constexpr (FP8) { asm volatile("v_mfma_scale_f32_16x16x128_f8f6f4 %0, %1, %2, %0, %3, %3 op_sel_hi:[0,0,0]" : "+v"(acc[ai][bj][m][n]) : "v"(cat8(Bt[n][0], Bt[n][1])), "v"(cat8(At[m][0], At[m][1])), "v"(scale1)); } \
        else { _Pragma("unroll") for (int k = 0; k < 2; ++k) acc[ai][bj][m][n] = __builtin_amdgcn_mfma_f32_16x16x32_bf16(Bt[n][k], At[m][k], acc[ai][bj][m][n], 0, 0, 0); } } __builtin_amdgcn_s_setprio(0); } while (0)
#define PG8_WAIT_V(n) asm volatile("s_waitcnt vmcnt(" #n ")" ::: "memory")
#define PG8_WAIT_L(n) asm volatile("s_waitcnt lgkmcnt(" #n ")" ::: "memory")
#define PG8_BAR __builtin_amdgcn_s_barrier()
#define PG8_SCHED __builtin_amdgcn_sched_barrier(0)
    Unit cur, nxt; int ui = 0;
    if (!S.next(0, cur)) return;
    Src sc, sn;
    S.fill(cur, sc, tid);
    f32x4 acc[2][2][4][2];
#pragma unroll
    for (int a = 0; a < 2; ++a)
#pragma unroll
        for (int b = 0; b < 2; ++b)
#pragma unroll
            for (int m = 0; m < 4; ++m)
#pragma unroll
                for (int n = 0; n < 2; ++n) acc[a][b][m][n] = (f32x4){0.f, 0.f, 0.f, 0.f};
    bf16x8 At[4][2], B0[2][2], B1[2][2];
    int scale1 = 0x7F7F7F7F; asm volatile("" : "+v"(scale1));
    PG8_STAGE_B(PG8_SB(0, 0), sc.b); PG8_STAGE_B(PG8_SB(0, 1), sc.b + hstep); PG8_STAGE_A(PG8_SA(0, 0), sc.a, sc.ao[0][0], sc.ao[0][1]); PG8_STAGE_A(PG8_SA(0, 1), sc.a, sc.ao[1][0], sc.ao[1][1]);
    if (wr == 1) PG8_BAR;
    PG8_WAIT_V(2); PG8_BAR;
    PG8_STAGE_B(PG8_SB(1, 0), sc.b + kstep); PG8_STAGE_A(PG8_SA(1, 0), sc.a + kstep, sc.ao[0][0], sc.ao[0][1]); PG8_STAGE_B(PG8_SB(1, 1), sc.b + hstep + kstep);
    PG8_WAIT_V(6); PG8_BAR;
    for (;;) {
        const bool has_next = S.next(ui + 1, nxt);
        if (has_next) S.fill(nxt, sn, tid); else sn = sc;
        if constexpr (Sched::GATHER) { *(LAS u32x4*)(S.stash + tid * 16) = (u32x4){sn.ao[0][0], sn.ao[0][1], sn.ao[1][0], sn.ao[1][1]}; }
        for (int t = 0; t < nt; t += 2) {
            const bool last = (t == nt - 2);
            const char* a1 = sc.a + (size_t)(t + 1) * kstep;
            const char* a2 = last ? sn.a : sc.a + (size_t)(t + 2) * kstep; const char* b2 = last ? sn.b : sc.b + (size_t)(t + 2) * kstep;
            const char* a3 = a2 + kstep; const char* b3 = b2 + kstep;
            unsigned o00, o01, o10, o11;
            if constexpr (Sched::GATHER) { o00 = sc.ao[0][0]; o01 = sc.ao[0][1]; o10 = sc.ao[1][0]; o11 = sc.ao[1][1];
                if (last) { const u32x4 q = *(const LAS u32x4*)(S.stash + tid * 16); o00 = q.x; o01 = q.y; o10 = q.z; o11 = q.w; } }
            else { o00 = sc.ao[0][0]; o01 = sc.ao[0][1]; o10 = sc.ao[1][0]; o11 = sc.ao[1][1]; }
            PG8_LDB(B0, 0, 0); PG8_LDB(B1, 0, 1); PG8_SCHED; PG8_LDA(At, 0, 0); PG8_STAGE_A(PG8_SA(1, 1), a1, sc.ao[1][0], sc.ao[1][1]);
            PG8_WAIT_V(8); PG8_WAIT_L(0); PG8_BAR; PG8_MMA(0, 0, At, B0); PG8_MMA(0, 1, At, B1); PG8_BAR; PG8_SCHED;
            PG8_LDA(At, 0, 1); PG8_STAGE_B(PG8_SB(0, 0), b2); PG8_STAGE_B(PG8_SB(0, 1), b2 + hstep); PG8_STAGE_A(PG8_SA(0, 0), a2, o00, o01);
            PG8_WAIT_V(8); PG8_WAIT_L(0); PG8_BAR; PG8_MMA(1, 0, At, B0); PG8_MMA(1, 1, At, B1); PG8_BAR; PG8_SCHED;
            PG8_LDB(B0, 1, 0); PG8_LDB(B1, 1, 1); PG8_SCHED; PG8_LDA(At, 1, 0); PG8_STAGE_A(PG8_SA(0, 1), a2, o10, o11);
            PG8_WAIT_V(8); PG8_WAIT_L(0); PG8_BAR; PG8_MMA(0, 0, At, B0); PG8_MMA(0, 1, At, B1); PG8_BAR; PG8_SCHED;
            PG8_LDA(At, 1, 1); PG8_STAGE_B(PG8_SB(1, 0), b3); PG8_STAGE_B(PG8_SB(1, 1), b3 + hstep); PG8_STAGE_A(PG8_SA(1, 0), a3, o00, o01);
            PG8_WAIT_V(8); PG8_WAIT_L(0); PG8_BAR; PG8_MMA(1, 0, At, B0); PG8_MMA(1, 1, At, B1); PG8_BAR; PG8_SCHED;
        }
        if constexpr (ALIGN_EPI) { if (wr == 0) PG8_BAR; }
        if constexpr (FP8) { asm volatile("s_nop 15\n\ts_nop 15" ::: "memory"); }
        E(acc, cur, wr, wc, fr, fq);
        if (!has_next) break;
#pragma unroll
        for (int a = 0; a < 2; ++a)
#pragma unroll
            for (int b = 0; b < 2; ++b)
#pragma unroll
                for (int m = 0; m < 4; ++m)
#pragma unroll
                    for (int n = 0; n < 2; ++n) acc[a][b][m][n] = (f32x4){0.f, 0.f, 0.f, 0.f};
        cur = nxt; sc.a = sn.a; sc.b = sn.b;
        if constexpr (Sched::GATHER) { const u32x4 q = *(const LAS u32x4*)(S.stash + tid * 16); sc.ao[0][0] = q.x; sc.ao[0][1] = q.y; sc.ao[1][0] = q.z; sc.ao[1][1] = q.w; }
        ++ui;
        if constexpr (ALIGN_EPI) { if (wr == 1) PG8_BAR; }
    }
    PG8_WAIT_V(0);
    if constexpr (!ALIGN_EPI) { if (wr == 0) PG8_BAR; }
    PG8_BAR;
#undef PG8_SA
#undef PG8_SB
#undef PG8_GLDS
#undef PG8_STAGE_A
#undef PG8_STAGE_B
#undef PG8_LDA
#undef PG8_LDB
#undef PG8_MMA
#undef PG8_WAIT_V
#undef PG8_WAIT_L
#undef PG8_BAR
#undef PG8_SCHED
}
}

#define XB_TMO      128
#define XB_XCNT(j)  (256  + 64 * (j))
#define XB_XSUB(j)  (1280 + 64 * (j))
#define XB_XGEN(j)  (2304 + 64 * (j))
#define XB_TOP      3328
#define XB_TOPGEN   3392
#define XCD_BAR_WORDS 3456
#define XB_SPIN_CAP (1u << 20)
DI unsigned xb_ld(unsigned* p)              { return __hip_atomic_load(p, __ATOMIC_RELAXED, __HIP_MEMORY_SCOPE_AGENT); }
DI unsigned xb_add(unsigned* p, unsigned v) { return __hip_atomic_fetch_add(p, v, __ATOMIC_RELAXED, __HIP_MEMORY_SCOPE_AGENT); }
DI unsigned xb_xcc_id() { return (unsigned)__builtin_amdgcn_s_getreg((3 << 11) | 20) & 0xFu; }
#define XB_SPIN(cond, bar) do { unsigned _sp = 0; while (cond) { __builtin_amdgcn_s_sleep(1); \
    if ((++_sp & 255u) == 0u) { if (xb_ld(&(bar)[XB_TMO])) break; if (_sp > XB_SPIN_CAP) { atomicAdd(&(bar)[XB_TMO], 1u); break; } } } } while (0)
struct XcdBarrier { unsigned* bar; unsigned x; volatile LAS unsigned* st; };
DI XcdBarrier xcd_barrier_post(unsigned* bar, volatile LAS unsigned* st, bool t0) {
    XcdBarrier b; b.bar = bar; b.x = xb_xcc_id(); b.st = st;
    if (t0) (void)xb_add(&bar[XB_XCNT(b.x)], 1u);
    return b;
}
DI void xcd_barrier_complete(unsigned* bar, unsigned x, unsigned& nloc, unsigned& nx) {
    const unsigned G = gridDim.x * gridDim.y * gridDim.z;
    unsigned sum, cnt, mine, sp = 0u;
    for (;;) {
        sum = 0u; cnt = 0u; mine = 0u;
#pragma unroll
        for (unsigned j = 0; j < 16; ++j) { const unsigned c = xb_ld(&bar[XB_XCNT(j)]); sum += c; cnt += (c > 0u) ? 1u : 0u; mine = (j == x) ? c : mine; }
        if (sum == G) break;
        __builtin_amdgcn_s_sleep(1);
        if ((++sp & 255u) == 0u) { if (xb_ld(&bar[XB_TMO])) break; if (sp > XB_SPIN_CAP) { atomicAdd(&bar[XB_TMO], 1u); break; } }
    }
    nloc = mine > 0u ? mine : 1u; nx = cnt > 0u ? cnt : 1u;
}
DI void xcd_barrier(const XcdBarrier& b, bool t0) {
    asm volatile("s_waitcnt vmcnt(0)" ::: "memory");
    __syncthreads();
    if (t0) {
        unsigned* bar = b.bar;
        __builtin_amdgcn_s_waitcnt(0);
        unsigned nloc = b.st[0], nx = b.st[1];
        if (nloc == 0u) { xcd_barrier_complete(bar, b.x, nloc, nx); b.st[0] = nloc; b.st[1] = nx; }
        const unsigned old = xb_add(&bar[XB_XSUB(b.x)], 1u);
        const unsigned gen = old / nloc;
        if (old + 1u == (gen + 1u) * nloc) {
            __builtin_amdgcn_fence(__ATOMIC_RELEASE, "agent");
            asm volatile("s_waitcnt vmcnt(0)" ::: "memory");
            const unsigned og = xb_add(&bar[XB_TOP], 1u);
            const unsigned tg = og / nx;
            if (og + 1u == (tg + 1u) * nx) xb_add(&bar[XB_TOPGEN], 1u);
            else XB_SPIN(xb_ld(&bar[XB_TOPGEN]) == tg, bar);
            __builtin_amdgcn_fence(__ATOMIC_ACQUIRE, "agent");
            xb_add(&bar[XB_XGEN(b.x)], 1u);
            asm volatile("s_waitcnt vmcnt(0)" ::: "memory");
        } else {
            XB_SPIN(xb_ld(&bar[XB_XGEN(b.x)]) == gen, bar);
            __builtin_amdgcn_fence(__ATOMIC_ACQUIRE, "agent");
            asm volatile("s_waitcnt vmcnt(0)" ::: "memory");
        }
    }
    __syncthreads();
}

constexpr int NWAVES = 8;
constexpr int BATCH = 2, T = 8192, D = 1024, M = BATCH * T;
constexpr int NZP = 2560;
constexpr int NEXP = 32, DEXP = 1024;
constexpr int PMAX = M * 4 + NEXP * 256;
constexpr float EPS = 1e-6f;
constexpr float LOG2E = 1.4426950408889634f;
constexpr float QSCALE = 0.125f * LOG2E;

constexpr size_t MiB = 1u << 20;
constexpr size_t WS_CTL = 0, CTL_ZERO_BYTES = 1 * MiB;
constexpr int CW_BAR = 4096;
constexpr int CW_CNT = 8192;
constexpr size_t WS_VSSQ = 256 * 1024;
constexpr size_t WS_WIN = 2 * MiB, WS_WOUT = 8 * MiB, WS_WCMP = 10 * MiB, WS_C1 = 11 * MiB, WS_RINV2 = 11 * MiB + 65536;
constexpr size_t WS_GATES = 12 * MiB, WS_KCN = 14 * MiB, WS_VCC = 14 * MiB + 512 * 1024, WS_TOKINFO = 15 * MiB, WS_TGATE = 15 * MiB + 512 * 1024;
constexpr size_t WS_LIST = 16 * MiB, WS_TCMP = 20 * MiB, WS_KCH = 24 * MiB, WS_VCH = 28 * MiB;
constexpr size_t WS_KS = 32 * MiB, WS_VS = 36 * MiB, WS_KW = 40 * MiB, WS_VW = 44 * MiB, WS_Q = 48 * MiB, WS_U = 64 * MiB, WS_VG = 80 * MiB;
#ifndef MK_ALIAS
#define MK_ALIAS 0
#endif
constexpr size_t WS_XN = 96 * MiB, WS_MIXED = 128 * MiB, WS_WGU = 160 * MiB  , WS_X1B = 224 * MiB  , WS_WD = 248 * MiB  ,
                 WS_H = MK_ALIAS ? 32 * MiB : 280 * MiB  , WS_O2 = MK_ALIAS ? 104 * MiB : 352 * MiB  , WS_X1H = 424 * MiB  , WS_END = 496 * MiB;
constexpr float WSCALE = 32.0f, WSCALE_INV = 1.0f / 32.0f, O2SCALE = 16.0f, O2SCALE_INV = 1.0f / 16.0f;

constexpr int RING_BYTES = 131072;
constexpr int LDS_BYTES = 163840;
constexpr int MISC_OFF = LDS_BYTES - 512;
constexpr int AUX_OFF = 147456;

struct Frame {
    LAS unsigned char* lds; volatile LAS unsigned* MISC; gu32* ctl;
    int wave, vcu, G;
    float* out; unsigned char* ws;
    const __attribute__((address_space(4))) char* ka;
};
typedef const __attribute__((address_space(4))) char* kptr_t;
DI const float* fin(const Frame& F, int i) { kptr_t ka = F.ka; asm volatile("" : "+s"(ka)); return *(const float* const __attribute__((address_space(4)))*)(ka + 8 * i); }

struct StaticOrder {
    static constexpr bool GATHER = false;
    int nM, nN, nwg, G, c, KB; const char* A; const char* B;
    DI void init(const void* A_, const void* B_, int M_, int N_, int KB_, int G_, int c_) { A = (const char*)A_; B = (const char*)B_; nM = M_ / 256; nN = N_ / 256; nwg = nM * nN; G = G_; c = c_; KB = KB_; }
    DI bool next(int i, pg8::Unit& u) const {
        const long L = (long)i * G + c; if (L >= nwg) return false;
        int wgid = (int)L; { const int q = nwg / 8, r = nwg % 8, xcd = wgid % 8, off = wgid / 8; wgid = (xcd < r ? xcd * (q + 1) : r * (q + 1) + (xcd - r) * q) + off; }
        const int nig = 8 * nN, gid = wgid / nig, fm = gid * 8, gsz = (nM - fm) < 8 ? (nM - fm) : 8;
        u.pm = fm + ((wgid % nig) % gsz); u.pn = (wgid % nig) / gsz; u.e = 0; u.ml = 0; u.cnt = 0; return true;
    }
    DI void fill(const pg8::Unit& u, pg8::Src& s, int tid) const {
        int RA[2]; unsigned CA2[2];
        for (int i = 0; i < 2; ++i) { int R, C; pg8::stage_rc(tid * 16 + i * 8192, R, C); RA[i] = R; CA2[i] = (unsigned)C * 2u; }
        const size_t tstep = (size_t)256 * KB;
        s.a = A + (size_t)u.pm * tstep; s.b = B + (size_t)u.pn * tstep;
#pragma unroll
        for (int h = 0; h < 2; ++h)
#pragma unroll
            for (int i = 0; i < 2; ++i) s.ao[h][i] = (unsigned)((h * 128 + RA[i]) * KB) + CA2[i];
    }
};
struct CmpOrder {
    static constexpr bool GATHER = false;
    int idx; const char* A0; const char* A1; const char* B;
    DI bool next(int i, pg8::Unit& u) const { if (i > 0 || idx < 0 || idx >= 16) return false; u.e = idx >> 3; u.pm = idx & 7; u.pn = 0; u.ml = 0; u.cnt = 0; return true; }
    DI void fill(const pg8::Unit& u, pg8::Src& s, int tid) const {
        int RA[2]; unsigned CA2[2];
        for (int i = 0; i < 2; ++i) { int R, C; pg8::stage_rc(tid * 16 + i * 8192, R, C); RA[i] = R; CA2[i] = (unsigned)C * 2u; }
        const size_t tstep = (size_t)256 * 1024 * 2;
        s.a = (u.e ? A1 : A0) + (size_t)u.pm * tstep; s.b = B + (size_t)u.e * tstep;
#pragma unroll
        for (int h = 0; h < 2; ++h)
#pragma unroll
            for (int i = 0; i < 2; ++i) s.ao[h][i] = (unsigned)((h * 128 + RA[i]) * 1024) * 2u + CA2[i];
    }
};
template <int NT, bool GATH, int DBG = 0> struct MoeOrder {
    static constexpr bool GATHER = GATH;
    int G, c, utot; const LAS int* tstart; const LAS int* ecnt; const char* A; const char* B; size_t bexp; const int* list; LAS unsigned char* stash; int dbg;
    DI bool next(int i, pg8::Unit& u) const {
        int tau, nt;
        if ((G & 7) == 0 && (G >> 3) % NT == 0) { const int x = c & 7, s = c >> 3, spx = G >> 3, tpx = spx / NT;
            tau = (i * 8 + x) * tpx + s / NT; nt = s % NT; }
        else { const int L = i * G + c; nt = L % NT; tau = L / NT; }
        if (tau * NT >= utot) return false;
        int e = 0;
        while (e < 31 && tstart[e + 1] <= tau) ++e;
        u.pm = tau; u.pn = nt; u.e = e; u.ml = tau - tstart[e]; u.cnt = ecnt[e]; return true;
    }
    DI void fill(const pg8::Unit& u, pg8::Src& s, int tid) const {
        int RA[2]; unsigned CA2[2];
        for (int i = 0; i < 2; ++i) { int R, C; pg8::stage_rc(tid * 16 + i * 8192, R, C); RA[i] = R; CA2[i] = (unsigned)C * 2u; }
        const size_t tstep = (size_t)256 * 1024;
        s.b = B + (size_t)u.e * bexp + (size_t)u.pn * tstep;
        if constexpr (GATH) {
            s.a = A;
#pragma unroll
            for (int h = 0; h < 2; ++h)
#pragma unroll
                for (int i = 0; i < 2; ++i) { const int r = u.ml * 256 + h * 128 + RA[i]; int tok = (DBG == 2) ? (r & 16383) : list[((size_t)u.e * M + r) * 2]; tok = (r < u.cnt) ? tok : 0; s.ao[h][i] = (unsigned)tok * 1024u + CA2[i]; }
        } else {
            s.a = A + (size_t)u.pm * tstep;
#pragma unroll
            for (int h = 0; h < 2; ++h)
#pragma unroll
                for (int i = 0; i < 2; ++i) s.ao[h][i] = (unsigned)((h * 128 + RA[i]) * 1024) + CA2[i];
        }
    }
};

struct EpiWin {
    static constexpr bool PERM = true;
    bf16 *Q, *KCH, *VCH, *KS, *VS, *KW, *VW, *U, *VG; float *GATES, *vssq; const float *qg, *kg; int noatomic;
    DI void operator()(const f32x4 (&acc)[2][2][4][2], const pg8::Unit& u, int wr, int wc, int fr, int fq) const {
        const int hu = u.pn * 4 + wc;
        if (hu > 36) return;
        const int rowb = u.pm * 256 + wr * 64 + fr;
        int kind; bf16* dst = nullptr; bool tokmajor = true; int sub = 0; const float* gain = nullptr; float gsc = 1.f;
        if (hu < 8) { kind = 0; dst = Q; sub = hu; gain = qg; gsc = QSCALE; }
        else if (hu < 20) { const int w = (hu - 8) >> 1; sub = (hu - 8) & 1; tokmajor = false;
            if (w == 0) { kind = 1; dst = KCH; } else if (w == 1) { kind = 1; dst = VCH; } else if (w == 2) { kind = 0; dst = KS; gain = kg + 64; }
            else if (w == 3) { kind = 1; dst = VS; } else if (w == 4) { kind = 0; dst = KW; gain = kg + 128; } else { kind = 1; dst = VW; } }
        else if (hu < 28) { kind = 2; dst = U; sub = hu - 20; }
        else if (hu < 36) { kind = 3; dst = VG; sub = hu - 28; }
        else kind = 4;
        float gv[2][8];
        if (kind == 0) {
#pragma unroll
            for (int bj = 0; bj < 2; ++bj)
#pragma unroll
                for (int i = 0; i < 8; ++i) gv[bj][i] = gain[32 * bj + 8 * fq + i] * gsc;
        }
#pragma unroll
        for (int ai = 0; ai < 2; ++ai)
#pragma unroll
            for (int m = 0; m < 4; ++m) {
                const int row = rowb + ai * 128 + m * 16;
                float x[2][8];
#pragma unroll
                for (int bj = 0; bj < 2; ++bj)
#pragma unroll
                    for (int n = 0; n < 2; ++n)
#pragma unroll
                        for (int i = 0; i < 4; ++i) x[bj][4 * n + i] = acc[ai][bj][m][n][i];
                if (kind == 4) {
                    if (fq < 3) {
                        f32x4 a, b;
#pragma unroll
                        for (int i = 0; i < 4; ++i) { a[i] = sigmoidf_(x[0][i]); b[i] = sigmoidf_(x[0][4 + i]); }
                        *(f32x4*)(GATES + (size_t)row * 24 + 8 * fq) = a; *(f32x4*)(GATES + (size_t)row * 24 + 8 * fq + 4) = b;
                    }
                    continue;
                }
                if (kind == 0) {
                    float s = 0.f;
#pragma unroll
                    for (int bj = 0; bj < 2; ++bj)
#pragma unroll
                        for (int i = 0; i < 8; ++i) s += x[bj][i] * x[bj][i];
                    s += __shfl_xor(s, 16); s += __shfl_xor(s, 32);
                    const float rinv = __builtin_amdgcn_rsqf(s * (1.0f / 64.0f) + EPS);
#pragma unroll
                    for (int bj = 0; bj < 2; ++bj)
#pragma unroll
                        for (int i = 0; i < 8; ++i) x[bj][i] = x[bj][i] * rinv * gv[bj][i];
                } else if (kind >= 2) {
#pragma unroll
                    for (int bj = 0; bj < 2; ++bj)
#pragma unroll
                        for (int i = 0; i < 8; ++i) x[bj][i] = gelu_tanh(x[bj][i]);
                    if (kind == 3) {
                        float s = 0.f;
#pragma unroll
                        for (int bj = 0; bj < 2; ++bj)
#pragma unroll
                            for (int i = 0; i < 8; ++i) s += x[bj][i] * x[bj][i];
                        s += __shfl_xor(s, 16); s += __shfl_xor(s, 32);
                        if (fq == 0 && !noatomic) atomicAdd(vssq + row, s);
                    }
                }
                const size_t off = tokmajor ? ((size_t)row * 512 + sub * 64) : ((size_t)(row + ((row >> 13) + sub) * 8192) * 64);
#pragma unroll
                for (int bj = 0; bj < 2; ++bj) {
                    u32x4 w; w.x = pk2(x[bj][0], x[bj][1]); w.y = pk2(x[bj][2], x[bj][3]); w.z = pk2(x[bj][4], x[bj][5]); w.w = pk2(x[bj][6], x[bj][7]);
                    *(u32x4*)(dst + off + 32 * bj + 8 * fq) = w;
                }
            }
    }
};
struct EpiCmp {
    static constexpr bool PERM = false;
    float* Tc;
    DI void operator()(const f32x4 (&acc)[2][2][4][2], const pg8::Unit& u, int wr, int wc, int fr, int fq) const {
        float* base = Tc + (size_t)u.e * 2048 * 256;
#pragma unroll
        for (int ai = 0; ai < 2; ++ai)
#pragma unroll
            for (int m = 0; m < 4; ++m) { const int row = u.pm * 256 + ai * 128 + wr * 64 + m * 16 + fr;
#pragma unroll
                for (int bj = 0; bj < 2; ++bj)
#pragma unroll
                    for (int n = 0; n < 2; ++n) *(f32x4*)(base + (size_t)row * 256 + bj * 128 + wc * 32 + n * 16 + 4 * fq) = acc[ai][bj][m][n]; }
    }
};
struct EpiWout {
    static constexpr bool PERM = true;
    const float* x; unsigned char* X1H; unsigned char* X1B;
    DI void operator()(const f32x4 (&acc)[2][2][4][2], const pg8::Unit& u, int wr, int wc, int fr, int fq) const {
#pragma unroll
        for (int ai = 0; ai < 2; ++ai)
#pragma unroll
            for (int m = 0; m < 4; ++m) { const size_t row = (size_t)u.pm * 256 + ai * 128 + wr * 64 + m * 16 + fr;
#pragma unroll
                for (int bj = 0; bj < 2; ++bj) { const size_t o = row * 1024 + u.pn * 256 + bj * 128 + wc * 32 + 8 * fq;
                    const f32x4 v0 = __builtin_nontemporal_load((const f32x4*)(x + o)) + acc[ai][bj][m][0], v1 = __builtin_nontemporal_load((const f32x4*)(x + o + 4)) + acc[ai][bj][m][1];
                    u32x4 h; h.x = pk2(v0[0], v0[1]); h.y = pk2(v0[2], v0[3]); h.z = pk2(v1[0], v1[1]); h.w = pk2(v1[2], v1[3]); *(u32x4*)(X1H + o * 2) = h;
                    u32x2 q; q.x = pk4_fp8(v0[0], v0[1], v0[2], v0[3]); q.y = pk4_fp8(v1[0], v1[1], v1[2], v1[3]); *(u32x2*)(X1B + o) = q; } }
    }
};
template <int DBG> struct EpiG1T {
    static constexpr bool PERM = true;
    unsigned char* H; const float* bias; const int* list; int dbg;
    DI void operator()(const f32x4 (&acc)[2][2][4][2], const pg8::Unit& u, int wr, int wc, int fr, int fq) const {
        if constexpr (DBG == 1) return;
        const float* bb = bias + (size_t)u.e * 2048 + u.pn * 256 + wc * 32 + 8 * fq;
        f32x4 bv[2][2];
#pragma unroll
        for (int bj = 0; bj < 2; ++bj)
#pragma unroll
            for (int n = 0; n < 2; ++n) bv[bj][n] = *(const f32x4*)(bb + bj * 128 + 4 * n);
        const int* lp = list + ((size_t)u.e * M + u.ml * 256 + wr * 64 + fr) * 2 + 1;
#pragma unroll
        for (int ai = 0; ai < 2; ++ai)
#pragma unroll
            for (int m = 0; m < 4; ++m) { const int rl = ai * 128 + wr * 64 + m * 16 + fr;
                const float rinv = __int_as_float(lp[(ai * 128 + m * 16) * 2]) * WSCALE_INV;
                unsigned char* hp = H + ((size_t)u.pm * 256 + rl) * 1024 + u.pn * 128 + wc * 16 + 4 * fq;
#pragma unroll
                for (int bj = 0; bj < 2; ++bj) { float a[4];
#pragma unroll
                    for (int n = 0; n < 2; ++n) { const f32x4 v = acc[ai][bj][m][n] * rinv + bv[bj][n];
#pragma unroll
                        for (int q = 0; q < 2; ++q) { const float gl = fminf(v[2 * q], 7.0f), li = fminf(fmaxf(v[2 * q + 1], -7.0f), 7.0f);
                            a[2 * n + q] = gl * __builtin_amdgcn_rcpf(1.0f + __builtin_amdgcn_exp2f(-1.702f * LOG2E * gl)) * (li + 1.0f); } }
                    *(unsigned*)(hp + bj * 64) = pk4_fp8(a[0], a[1], a[2], a[3]); } }
    }
};
struct EpiG2 {
    static constexpr bool PERM = true;
    unsigned char* O2; const float* bias;
    DI void operator()(const f32x4 (&acc)[2][2][4][2], const pg8::Unit& u, int wr, int wc, int fr, int fq) const {
        const float* bb = bias + (size_t)u.e * 1024 + u.pn * 256 + wc * 32 + 8 * fq;
        f32x4 bv[2][2];
#pragma unroll
        for (int bj = 0; bj < 2; ++bj)
#pragma unroll
            for (int n = 0; n < 2; ++n) bv[bj][n] = *(const f32x4*)(bb + bj * 128 + 4 * n);
#pragma unroll
        for (int ai = 0; ai < 2; ++ai)
#pragma unroll
            for (int m = 0; m < 4; ++m) { const int rl = ai * 128 + wr * 64 + m * 16 + fr;
                unsigned char* op = O2 + ((size_t)u.pm * 256 + rl) * 1024 + u.pn * 256 + wc * 32 + 8 * fq;
#pragma unroll
                for (int bj = 0; bj < 2; ++bj) { const f32x4 v0 = (acc[ai][bj][m][0] * WSCALE_INV + bv[bj][0]) * O2SCALE, v1 = (acc[ai][bj][m][1] * WSCALE_INV + bv[bj][1]) * O2SCALE;
                    u32x2 w; w.x = pk4_fp8(v0[0], v0[1], v0[2], v0[3]); w.y = pk4_fp8(v1[0], v1[1], v1[2], v1[3]); *(u32x2*)(op + bj * 128) = w; } }
    }
};

#define LDS_WAIT() asm volatile("s_waitcnt lgkmcnt(0)" ::: "memory")
struct P0D { const float* src; const float* ksp; unsigned char* dst; int nsrc; float mul; bool hask; bool f8; };
DI int win_srccol(int p) {
    const int pn = p >> 8, cc = p & 255, bj = cc >> 7, wc = (cc >> 5) & 3, j = cc & 31, hu = 4 * pn + wc, dim = 32 * bj + j;
    if (hu < 20) return hu * 64 + dim;
    if (hu < 28) return 1304 + (hu - 20) * 64 + dim;
    if (hu < 36) return 1816 + (hu - 28) * 64 + dim;
    if (hu == 36 && dim < 24) return 1280 + dim;
    return -1;
}
constexpr int P0_I_GU = 32 * 8 * 64, P0_I_DN = 32 * 8 * 32, P0_I_WIN = 16 * 40, P0_I_WOUT = 16 * 16, P0_I_CMP = 128, P0_NITEMS = P0_I_GU + P0_I_DN + P0_I_WIN + P0_I_WOUT + P0_I_CMP;
struct P0Ptrs { const float *w_in, *w_cmp1, *ga, *gg, *w_out, *g2, *wgu, *wd; unsigned char* ws; };
DI P0D p0_decode(const P0Ptrs& P, int it, int lane) {
    P0D d; d.ksp = P.g2; d.hask = false; d.f8 = false; d.mul = 1.0f;
    int r = it, k0, prow0, sc, n4, q; const float* W; unsigned char* WT;
    if (r < P0_I_GU + P0_I_DN) {
        d.f8 = true; n4 = lane & 7; q = lane >> 3; d.mul = WSCALE;
        if (r < P0_I_GU) { const int e = r >> 9, kb = (r >> 6) & 7, nb = r & 63; k0 = 128 * kb; prow0 = 32 * nb; d.nsrc = 2048;
            W = P.wgu + (size_t)e * 1024 * 2048; WT = P.ws + WS_WGU + (size_t)e * 2048 * 1024; d.ksp = P.g2 + k0 + 16 * q; d.hask = true; }
        else { r -= P0_I_GU; const int e = r >> 8, kb = (r >> 5) & 7, nb = r & 31; k0 = 128 * kb; prow0 = 32 * nb; d.nsrc = 1024;
            W = P.wd + (size_t)e * 1024 * 1024; WT = P.ws + WS_WD + (size_t)e * 1024 * 1024; }
        sc = prow0 + 4 * n4;
        d.dst = WT + (size_t)prow0 * 1024 + k0;
    } else {
        r -= P0_I_GU + P0_I_DN; n4 = lane & 15; q = lane >> 4;
        if (r < P0_I_WIN) { const int kb = r / 40, nb = r % 40; k0 = 64 * kb; prow0 = 64 * nb; sc = win_srccol(prow0 + 4 * n4); d.nsrc = 2328;
            W = P.w_in; WT = P.ws + WS_WIN; }
        else if ((r -= P0_I_WIN) < P0_I_WOUT) { const int kb = r >> 4, nb = r & 15; k0 = 64 * kb; prow0 = 64 * nb; sc = prow0 + 4 * n4; d.nsrc = 1024;
            W = P.w_out; WT = P.ws + WS_WOUT; d.ksp = (k0 < 512 ? P.ga + k0 : P.gg + (k0 - 512)) + 16 * q; d.hask = true; }
        else { r -= P0_I_WOUT; const int ti = r >> 6, half = (r >> 5) & 1, kb = (r >> 1) & 15, nb = r & 1; k0 = 64 * kb; prow0 = half * 128 + 64 * nb; sc = 64 * nb + 4 * n4; d.nsrc = 128;
            W = P.w_cmp1 + (size_t)ti * 2048 * 128 + (size_t)half * 1024 * 128; WT = P.ws + WS_WCMP + (size_t)ti * 256 * 1024 * 2; }
        d.dst = WT + ((size_t)prow0 * 1024 + k0) * 2;
    }
    if (sc < 0) { d.mul = 0.0f; sc = 0; }
    d.src = W + (size_t)(k0 + 16 * q) * d.nsrc + sc;
    return d;
}
DI void p0_issue(const P0D& d, f32x4 (&v)[16], f32x4 (&ks)[4]) {
#pragma unroll
    for (int i = 0; i < 16; ++i) v[i] = __builtin_nontemporal_load((const f32x4*)(d.src + (size_t)i * d.nsrc));
#pragma unroll
    for (int i = 0; i < 4; ++i) { const f32x4 t = *(const f32x4*)(d.ksp + 4 * i); ks[i] = (d.hask ? t : (f32x4){1.f, 1.f, 1.f, 1.f}) * d.mul; }
}
DI void p0_finish(const P0D& d, const f32x4 (&v)[16], const f32x4 (&ks)[4], LAS char* tile, int lane) {
    if (d.f8) {
        const int n4 = lane & 7, q = lane >> 3;
#pragma unroll
        for (int j = 0; j < 4; ++j) {
            float x[16];
#pragma unroll
            for (int i = 0; i < 16; ++i) x[i] = v[i][j] * ks[i >> 2][i & 3];
            *(LAS u32x4*)(tile + (4 * n4 + j) * 144 + 16 * q) = (u32x4){pk4_fp8(x[0], x[1], x[2], x[3]), pk4_fp8(x[4], x[5], x[6], x[7]), pk4_fp8(x[8], x[9], x[10], x[11]), pk4_fp8(x[12], x[13], x[14], x[15])};
        }
#pragma unroll
        for (int t = 0; t < 4; ++t) { const int id = t * 64 + lane, row = id >> 3, ch = id & 7;
            const u32x4 o = *(const LAS u32x4*)(tile + row * 144 + ch * 16);
            *(u32x4*)(d.dst + (size_t)row * 1024 + ch * 16) = o; }
    } else {
        const int n4 = lane & 15, q = lane >> 4;
#pragma unroll
        for (int j = 0; j < 4; ++j) {
            float x[16];
#pragma unroll
            for (int i = 0; i < 16; ++i) x[i] = v[i][j] * ks[i >> 2][i & 3];
            LAS char* p = tile + (4 * n4 + j) * 144 + 32 * q;
            *(LAS u32x4*)p = (u32x4){pk2(x[0], x[1]), pk2(x[2], x[3]), pk2(x[4], x[5]), pk2(x[6], x[7])};
            *(LAS u32x4*)(p + 16) = (u32x4){pk2(x[8], x[9]), pk2(x[10], x[11]), pk2(x[12], x[13]), pk2(x[14], x[15])};
        }
#pragma unroll
        for (int t = 0; t < 8; ++t) { const int id = t * 64 + lane, row = id >> 3, ch = id & 7;
            const u32x4 o = *(const LAS u32x4*)(tile + row * 144 + ch * 16);
            *(u32x4*)(d.dst + (size_t)row * 2048 + ch * 16) = o; }
    }
}
DI void p0_convert(Frame& F, LAS char* tile, const int lo, const int hi, const int rank, const int stride) {
    const int lane = lane_id();
    P0Ptrs P; P.w_in = fin(F, 2); P.w_cmp1 = fin(F, 6); P.ga = fin(F, 13); P.gg = fin(F, 14); P.w_out = fin(F, 15); P.g2 = fin(F, 16); P.wgu = fin(F, 19); P.wd = fin(F, 21); P.ws = F.ws;
    f32x4 va[16], vb[16], ka[4], kb[4];
    int it = lo + rank;
    P0D da, db;
    if (it < hi) { da = p0_decode(P, it, lane); p0_issue(da, va, ka); }
    while (it < hi) {
        const int itb = it + stride;
        if (itb < hi) { db = p0_decode(P, itb, lane); p0_issue(db, vb, kb); }
        p0_finish(da, va, ka, tile, lane);
        if (itb >= hi) break;
        const int itc = itb + stride;
        if (itc < hi) { da = p0_decode(P, itc, lane); p0_issue(da, va, ka); }
        p0_finish(db, vb, kb, tile, lane);
        it = itc;
    }
}
constexpr int P0_MOE = P0_I_GU + P0_I_DN;
#ifndef MK_LATECONV
#define MK_LATECONV 0
#endif
constexpr int CV_N1 = MK_LATECONV ? 0 : 128 * 8 * 3, CV_N2 = MK_LATECONV ? 0 : 112 * 8 * 3, CV_N3 = MK_LATECONV ? 0 : 256 * 8 * 2, CV_N4 = MK_LATECONV ? 0 : 54 * 8 * 6;
constexpr int CV_LATE = MK_LATECONV ? P0_I_GU + P0_I_DN : 0;
constexpr int CV_A0 = P0_MOE - CV_LATE - (CV_N1 + CV_N2 + CV_N3 + CV_N4), CV_A1 = CV_A0 + CV_N1, CV_A2 = CV_A1 + CV_N2, CV_A3 = CV_A2 + CV_N3;
static_assert(CV_A0 >= 0 && CV_A3 + CV_N4 + CV_LATE == P0_MOE, "conversion split");
static_assert(MK_LATECONV || CV_N4 <= 2 * 170 * 8, "attention-phase conversion share");
DI void p0_prologue(Frame& F) {
    const int gw = F.vcu * NWAVES + F.wave, NGW = F.G * NWAVES, lane = lane_id();
    LAS char* tile = (LAS char*)(F.lds + F.wave * 16384);
    unsigned char* ws = F.ws;
    const float* in0 = fin(F, 0); const float* in5 = fin(F, 5); const float* in6 = fin(F, 6); const float* in7 = fin(F, 7);
    p0_convert(F, tile, P0_MOE, P0_NITEMS, gw, NGW);
    p0_convert(F, tile, 0, CV_A0, gw, NGW);
    const float* g1 = fin(F, 1);
    f32x4 gv[4];
#pragma unroll
    for (int j = 0; j < 4; ++j) gv[j] = *(const f32x4*)(g1 + 4 * lane + 256 * j);
    for (int m = gw; m < M; m += NGW) {
        const f32x4* xr = (const f32x4*)(in0 + (size_t)m * D) + lane;
        f32x4 v[4]; float s = 0.f;
#pragma unroll
        for (int j = 0; j < 4; ++j) { v[j] = __builtin_nontemporal_load(xr + 64 * j); s += (v[j].x * v[j].x + v[j].y * v[j].y) + (v[j].z * v[j].z + v[j].w * v[j].w); }
        const float rinv = __builtin_amdgcn_rsqf(wave_sum(s) * (1.f / D) + EPS);
        u32x2* o8 = (u32x2*)((bf16*)(ws + WS_XN) + (size_t)m * D) + lane;
#pragma unroll
        for (int j = 0; j < 4; ++j) { const f32x4 y = v[j] * rinv * gv[j]; u32x2 w; w.x = pk2(y.x, y.y); w.y = pk2(y.z, y.w); o8[64 * j] = w; }
    }
    for (int it = gw; it < 256; it += NGW) {
        const int ti = it >> 7, n = it & 127; const float* pos = in5 + ti * 2048; const float* w1 = in6 + (size_t)ti * 2048 * 128 + n;
        float s = 0.f;
        for (int i = 0; i < 32; ++i) { const int k = lane + 64 * i; s += pos[k] * w1[(size_t)k * 128]; }
        s = wave_sum(s);
        if (lane == 0) ((float*)(ws + WS_C1))[it] = s + in7[it];
    }
}

#define MFMA32(a, b, c) __builtin_amdgcn_mfma_f32_32x32x16_bf16((a), (b), (c), 0, 0, 0)
typedef short v4i16_t __attribute__((ext_vector_type(4)));
DI s16x4 vtr(LAS const char* p) { return __builtin_bit_cast(s16x4, __builtin_amdgcn_ds_read_tr16_b64_v4i16((LAS v4i16_t*)p)); }
DI bf16x8 mk8(s16x4 lo, s16x4 hi) { return (bf16x8){lo[0], lo[1], lo[2], lo[3], hi[0], hi[1], hi[2], hi[3]}; }

DI void gmlp_phase(Frame& F) {
    const int c = F.vcu, g = F.wave, lane = lane_id(), col = lane & 31, hi = lane >> 5;
    const bool act = c < 128;
    const size_t row0 = (size_t)c * 128;
    LAS char* vl = (LAS char*)F.lds + g * 16384;
    LAS float* ssqL = (LAS float*)(F.lds + RING_BYTES);
    unsigned opk[4][2][8];
    if (act) {
        const bf16* VG = (const bf16*)(F.ws + WS_VG); const float* vssq = (const float*)(F.ws + WS_VSSQ); const float* vgain = fin(F, 10);
        const bf16* U = (const bf16*)(F.ws + WS_U);
#pragma unroll 4
        for (int i = 0; i < 16; ++i) { const int id = i * 64 + lane, s = id >> 3, ch = id & 7;
            const u32x4 raw = *(const u32x4*)(VG + (row0 + s) * 512 + g * 64 + ch * 8);
            const float rinv = __builtin_amdgcn_rsqf(vssq[row0 + s] * (1.0f / 512.0f) + EPS);
            const f32x4 ga = *(const f32x4*)(vgain + g * 64 + ch * 8), gb = *(const f32x4*)(vgain + g * 64 + ch * 8 + 4);
            u32x4 w; w.x = pk2(bflo(raw.x) * rinv * ga.x, bfhi(raw.x) * rinv * ga.y); w.y = pk2(bflo(raw.y) * rinv * ga.z, bfhi(raw.y) * rinv * ga.w);
            w.z = pk2(bflo(raw.z) * rinv * gb.x, bfhi(raw.z) * rinv * gb.y); w.w = pk2(bflo(raw.w) * rinv * gb.z, bfhi(raw.w) * rinv * gb.w);
            *(LAS u32x4*)(vl + (ch >> 2) * 8192 + s * 64 + (ch & 3) * 16) = w; }
        LAS const char* vp = vl + ((lane >> 4) & 1) * 32 + (lane & 3) * 8 + (4 * hi + ((lane & 15) >> 2)) * 64;
        const float* wsg = fin(F, 11) + (size_t)g * 128 * 128; const float* bs = fin(F, 12) + g * 128;
#pragma unroll
        for (int tb = 0; tb < 4; ++tb) {
            const int t = 32 * tb + col;
            f32x16 a0 = {}, a1 = {};
#pragma unroll
            for (int ks = 0; ks < 2 * (tb + 1); ++ks) {
                const int s0 = 16 * ks + 4 * hi;
                f32x4 wa = *(const f32x4*)(wsg + t * 128 + s0), wb = *(const f32x4*)(wsg + t * 128 + s0 + 8);
#pragma unroll
                for (int i = 0; i < 4; ++i) { wa[i] = (s0 + i <= t) ? wa[i] : 0.f; wb[i] = (s0 + 8 + i <= t) ? wb[i] : 0.f; }
                u32x4 wp; wp.x = pk2(wa[0], wa[1]); wp.y = pk2(wa[2], wa[3]); wp.z = pk2(wb[0], wb[1]); wp.w = pk2(wb[2], wb[3]);
                const bf16x8 wf = __builtin_bit_cast(bf16x8, wp);
                const bf16x8 v0 = mk8(vtr(vp + ks * 1024), vtr(vp + ks * 1024 + 512));
                const bf16x8 v1 = mk8(vtr(vp + 8192 + ks * 1024), vtr(vp + 8192 + ks * 1024 + 512));
                a0 = MFMA32(v0, wf, a0); a1 = MFMA32(v1, wf, a1);
            }
            const float bt = bs[t]; const size_t row = row0 + t; float ssq = 0.f;
#pragma unroll
            for (int db = 0; db < 2; ++db)
#pragma unroll
                for (int a = 0; a < 4; ++a) { const int d0 = 32 * db + 8 * a + 4 * hi;
                    const u32x2 uu = *(const u32x2*)(U + row * 512 + g * 64 + d0);
                    const float o0 = bflo(uu.x) * ((db ? a1[4 * a] : a0[4 * a]) + bt), o1 = bfhi(uu.x) * ((db ? a1[4 * a + 1] : a0[4 * a + 1]) + bt);
                    const float o2 = bflo(uu.y) * ((db ? a1[4 * a + 2] : a0[4 * a + 2]) + bt), o3 = bfhi(uu.y) * ((db ? a1[4 * a + 3] : a0[4 * a + 3]) + bt);
                    ssq += (o0 * o0 + o1 * o1) + (o2 * o2 + o3 * o3);
                    opk[tb][db][2 * a] = pk2(o0, o1); opk[tb][db][2 * a + 1] = pk2(o2, o3); }
            ssq += __shfl_xor(ssq, 32);
            if (hi == 0) ssqL[g * 128 + t] = ssq;
        }
    }
    __syncthreads();
    if (act) {
        bf16* MX = (bf16*)(F.ws + WS_MIXED);
#pragma unroll
        for (int tb = 0; tb < 4; ++tb) {
            const int t = 32 * tb + col; float tot = 0.f;
#pragma unroll
            for (int gg = 0; gg < 8; ++gg) tot += ssqL[gg * 128 + t];
            const float rinv = __builtin_amdgcn_rsqf(tot * (1.0f / 512.0f) + EPS);
#pragma unroll
            for (int db = 0; db < 2; ++db)
#pragma unroll
                for (int a = 0; a < 4; ++a) { const int d0 = 32 * db + 8 * a + 4 * hi; const unsigned w0 = opk[tb][db][2 * a], w1 = opk[tb][db][2 * a + 1];
                    u32x2 w; w.x = pk2(bflo(w0) * rinv, bfhi(w0) * rinv); w.y = pk2(bflo(w1) * rinv, bfhi(w1) * rinv);
                    *(u32x2*)(MX + (row0 + t) * 1024 + 512 + g * 64 + d0) = w; }
        }
    }
    __syncthreads();
}

DI void cmp2_phase(Frame& F) {
    const int gw = F.vcu * NWAVES + F.wave, NGW = F.G * NWAVES, lane = lane_id();
    const float* TC = (const float*)(F.ws + WS_TCMP); const float* c1 = (const float*)(F.ws + WS_C1);
    const float* in4 = fin(F, 4); const float* in8 = fin(F, 8); const float* in9 = fin(F, 9);
    for (int id = gw; id < 4096; id += NGW) {
        const int ti = id >> 11, seg = id & 2047, c = seg & 511;
        bf16* dst = (bf16*)(F.ws + (ti ? WS_VCC : WS_KCN)) + (size_t)seg * 64;
        if (c == 511) { dst[lane] = 0; continue; }
        const float* Tt = TC + (size_t)ti * 2048 * 256;
        const float h0 = gelu_tanh(Tt[(size_t)seg * 256 + lane] + Tt[(size_t)(seg + 1) * 256 + 128 + lane] + c1[ti * 128 + lane]);
        const float h1 = gelu_tanh(Tt[(size_t)seg * 256 + 64 + lane] + Tt[(size_t)(seg + 1) * 256 + 192 + lane] + c1[ti * 128 + 64 + lane]);
        const float* w2 = in8 + (size_t)ti * 128 * 64;
        float o = in9[ti * 64 + lane];
#pragma unroll
        for (int k = 0; k < 64; ++k) o += __int_as_float(__builtin_amdgcn_readlane(__float_as_int(h0), k)) * w2[k * 64 + lane];
#pragma unroll
        for (int k = 0; k < 64; ++k) o += __int_as_float(__builtin_amdgcn_readlane(__float_as_int(h1), k)) * w2[(64 + k) * 64 + lane];
        if (ti == 0) { const float ss = wave_sum(o * o); o = o * __builtin_amdgcn_rsqf(ss * (1.0f / 64.0f) + EPS) * in4[lane]; }
        dst[lane] = (bf16)(pk2(o, 0.f) & 0xffffu);
    }
}

struct AttnP { const bf16 *Q, *KCN, *VCC, *KS, *VS, *KW, *VW; const float* GATES; bf16* MX; };
constexpr int AL_K = 0, AL_V = 24576, AL_WAVE = 57344  , AL_WSTRIDE = 12288, AL_XCH = 155648;
#define GLDS16(src, dst) __builtin_amdgcn_global_load_lds((const unsigned*)(src), (LAS unsigned*)(dst), 16, 0, 0)
DI void dma_k(const bf16* Kt, LAS char* kbuf, int w, int lane) {
    const char* base = (const char*)Kt; asm volatile("" : "+s"(base));
    GLDS16(base + (unsigned)(lane * 128 + w * 16), kbuf + w * 1024);
}
DI void dma_v(const bf16* Vt, LAS char* vbuf, int w, int lane) {
    const char* base = (const char*)Vt; asm volatile("" : "+s"(base));
    GLDS16(base + (unsigned)((16 * (w & 3) + (lane >> 2)) * 128 + (w >> 2) * 64 + (lane & 3) * 16), vbuf + (w >> 2) * 4096 + (w & 3) * 1024);
}
#define TILE_SYNC(more, per) do { if (DBG == 10) asm volatile("s_waitcnt lgkmcnt(0)" ::: "memory"); else if (more) { if ((per) == 2) asm volatile("s_waitcnt vmcnt(2) lgkmcnt(0)" ::: "memory"); else asm volatile("s_waitcnt vmcnt(1) lgkmcnt(0)" ::: "memory"); } \
    else asm volatile("s_waitcnt vmcnt(0) lgkmcnt(0)" ::: "memory"); if (DBG != 9) __builtin_amdgcn_s_barrier(); asm volatile("" ::: "memory"); } while (0)
#define SEQ_SYNC() do { asm volatile("s_waitcnt vmcnt(0) lgkmcnt(0)" ::: "memory"); __builtin_amdgcn_s_barrier(); asm volatile("" ::: "memory"); } while (0)
DI int crf(int r) { return (r & 3) + 8 * (r >> 2); }
DI float sum_x8(float v) { return v + __int_as_float(__builtin_amdgcn_update_dpp(0, __float_as_int(v), 0x128, 0xf, 0xf, false)); }
DI float sum_x16(float v) { const auto r = __builtin_amdgcn_permlane16_swap(__float_as_uint(v), __float_as_uint(v), false, false); return __uint_as_float(r[0]) + __uint_as_float(r[1]); }
DI float sum_x32(float v) { const auto r = __builtin_amdgcn_permlane32_swap(__float_as_uint(v), __float_as_uint(v), false, false); return __uint_as_float(r[0]) + __uint_as_float(r[1]); }
DI float max_x32(float v) { const auto r = __builtin_amdgcn_permlane32_swap(__float_as_uint(v), __float_as_uint(v), false, false); return fmaxf(__uint_as_float(r[0]), __uint_as_float(r[1])); }
DI void qk_lds(LAS const char* kb, LAS const char* qb, const f32x16& c0, const f32x16& c1, f32x16& p0, f32x16& p1, int col, int hi) {
    const unsigned ka = (unsigned)(__SIZE_TYPE__)(kb + hi * 1024 + col * 16), qa = (unsigned)(__SIZE_TYPE__)qb;
    bf16x8 k0[4], k1[4], qf[4];
#pragma unroll
    for (int d0 = 0; d0 < 4; ++d0) {
        asm volatile("ds_read_b128 %0, %1 offset:%c2" : "=&v"(qf[d0]) : "v"(qa), "i"(d0 * 1024) : "memory");
        asm volatile("ds_read_b128 %0, %1 offset:%c2" : "=&v"(k0[d0]) : "v"(ka), "i"(d0 * 2048) : "memory");
        asm volatile("ds_read_b128 %0, %1 offset:%c2" : "=&v"(k1[d0]) : "v"(ka), "i"(d0 * 2048 + 512) : "memory");
    }
    asm volatile("s_waitcnt lgkmcnt(0)" ::: "memory"); __builtin_amdgcn_sched_barrier(0);
    p0 = MFMA32(k0[0], qf[0], c0); p1 = MFMA32(k1[0], qf[0], c1);
#pragma unroll
    for (int d0 = 1; d0 < 4; ++d0) { p0 = MFMA32(k0[d0], qf[d0], p0); p1 = MFMA32(k1[d0], qf[d0], p1); }
}
DI void pv_tile(LAS const char* vp, const u32x4 (&pw)[4], f32x16& o0, f32x16& o1) {
    const unsigned vb = (unsigned)(__SIZE_TYPE__)vp;
#pragma unroll
    for (int d0 = 0; d0 < 2; ++d0) {
        s16x4 lo[4], hi[4];
#pragma unroll
        for (int ks = 0; ks < 4; ++ks) {
            asm volatile("ds_read_b64_tr_b16 %0, %1 offset:%c2" : "=&v"(lo[ks]) : "v"(vb), "i"(d0 * 4096 + ks * 1024) : "memory");
            asm volatile("ds_read_b64_tr_b16 %0, %1 offset:%c2" : "=&v"(hi[ks]) : "v"(vb), "i"(d0 * 4096 + ks * 1024 + 512) : "memory");
        }
        asm volatile("s_waitcnt lgkmcnt(0)" ::: "memory"); __builtin_amdgcn_sched_barrier(0);
#pragma unroll
        for (int ks = 0; ks < 4; ++ks) {
            const bf16x8 pf = __builtin_bit_cast(bf16x8, pw[ks]);
            if (d0 == 0) o0 = MFMA32(mk8(lo[ks], hi[ks]), pf, o0); else o1 = MFMA32(mk8(lo[ks], hi[ks]), pf, o1);
        }
    }
}
DI float fma_s(float a, float ks, float c) { float d; asm("v_fma_f32 %0, %1, %2, %3" : "=v"(d) : "v"(a), "s"(ks), "v"(c)); return d; }
DI float add_(float a, float b) { float d; asm("v_add_f32 %0, %1, %2" : "=v"(d) : "v"(a), "v"(b)); return d; }
DI void mk_cinit(f32x16& c, float A, float B) {
    c[0] = A;
#pragma unroll
    for (int r = 1; r < 16; ++r) c[r] = fma_s(B, (float)crf(r), A);
}
template <bool WIN, int KS> DI void tile_mask(f32x16& p, int dbase) {
#pragma unroll
    for (int r = 0; r < 16; ++r) { bool ok = dbase >= KS * crf(r); if (WIN) ok = ok && (dbase - KS * crf(r) < 512); p[r] = ok ? p[r] : -INFINITY; }
}
DI float max3_(float a, float b, float c) { float d; asm("v_max3_f32 %0, %1, %2, %3" : "=v"(d) : "v"(a), "v"(b), "v"(c)); return d; }
DI float max2_(float a, float b) { float d; asm("v_max_f32 %0, %1, %2" : "=v"(d) : "v"(a), "v"(b)); return d; }
DI float tile_max(f32x16& p0, f32x16& p1) {
    asm volatile("s_nop 15" : "+v"(p0), "+v"(p1));
    float c[4];
#pragma unroll
    for (int k = 0; k < 4; ++k) {
        float a = max3_(p0[k], p1[k], p0[k + 4]);
        a = max3_(a, p1[k + 4], p0[k + 8]);
        a = max3_(a, p1[k + 8], p0[k + 12]);
        c[k] = max2_(a, p1[k + 12]);
    }
    const float v = max2_(max3_(c[0], c[1], c[2]), c[3]);
    const auto r = __builtin_amdgcn_permlane32_swap(__float_as_uint(v), __float_as_uint(v), false, false);
    return max2_(__uint_as_float(r[0]), __uint_as_float(r[1]));
}
DI void pack_p(const f32x16& p0, const f32x16& p1, u32x4 (&pw)[4]) {
#pragma unroll
    for (int s = 0; s < 2; ++s) {
        pw[s] = (u32x4){pk2(p0[8 * s], p0[8 * s + 1]), pk2(p0[8 * s + 2], p0[8 * s + 3]), pk2(p0[8 * s + 4], p0[8 * s + 5]), pk2(p0[8 * s + 6], p0[8 * s + 7])};
        pw[2 + s] = (u32x4){pk2(p1[8 * s], p1[8 * s + 1]), pk2(p1[8 * s + 2], p1[8 * s + 3]), pk2(p1[8 * s + 4], p1[8 * s + 5]), pk2(p1[8 * s + 6], p1[8 * s + 7])};
    }
}
template <bool WIN, int DBG, bool FIX> DI void online_A(LAS const char* kb, int P0, bool selb, bool need_mask, int t, float sl2, LAS const char* qf,
                                     float& m, float& l, f32x16& o0, f32x16& o1, u32x4 (&pw)[4], int col, int hi) {
    int db0 = t - P0 - 4 * hi; asm volatile("" : "+v"(db0));
    const int db1 = db0 - 32;
    const float ninf = selb ? 0.f : -INFINITY;
    f32x16 p0, p1;
    { f32x16 c0, c1; mk_cinit(c0, -sl2 * (float)db0 - m + ninf, sl2); mk_cinit(c1, -sl2 * (float)db1 - m + ninf, sl2); qk_lds(kb, qf, c0, c1, p0, p1, col, hi); }
    if (need_mask) { tile_mask<WIN, 1>(p0, db0); tile_mask<WIN, 1>(p1, db1); }
    const float mt = FIX ? 0.f : tile_max(p0, p1);
    if (!FIX && __any(mt > 8.0f)) {
        const float dl = fmaxf(mt, 0.f), alpha = __builtin_amdgcn_exp2f(-dl);
        m += dl; l *= alpha;
#pragma unroll
        for (int r = 0; r < 16; ++r) { p0[r] -= dl; p1[r] -= dl; o0[r] *= alpha; o1[r] *= alpha; }
    }
    float rs0 = 0.f, rs1 = 0.f, rs2 = 0.f, rs3 = 0.f;
#pragma unroll
    for (int r = 0; r < 16; ++r) { if (DBG != 7) { p0[r] = __builtin_amdgcn_exp2f(p0[r]); p1[r] = __builtin_amdgcn_exp2f(p1[r]); } }
    __builtin_amdgcn_sched_barrier(0);
    rs0 = add_(p0[0], p1[0]); rs1 = add_(p0[1], p1[1]); rs2 = add_(p0[2], p1[2]); rs3 = add_(p0[3], p1[3]);
#pragma unroll
    for (int r = 4; r < 16; r += 4) { rs0 = add_(add_(rs0, p0[r]), p1[r]); rs1 = add_(add_(rs1, p0[r + 1]), p1[r + 1]); rs2 = add_(add_(rs2, p0[r + 2]), p1[r + 2]); rs3 = add_(add_(rs3, p0[r + 3]), p1[r + 3]); }
    l += sum_x32(add_(add_(rs0, rs1), add_(rs2, rs3)));
    pack_p(p0, p1, pw);
}
DI int prev_bit(unsigned long long lo, unsigned long long hi, int n) {
    if (n > 64) { const unsigned long long h = (n >= 128) ? hi : (hi & ((1ull << (n - 64)) - 1ull)); if (h) return 127 - __builtin_clzll(h); n = 64; }
    const unsigned long long l = (n >= 64) ? lo : (lo & ((1ull << n) - 1ull));
    return l ? 63 - __builtin_clzll(l) : -1;
}
template <int DBG, bool FIX> DI void attn_group(const AttnP& P, LAS char* lds, const int g, const int b, const int j, const int w, const int lane_, f32x16& ot0, f32x16& ot1, const int dbg, const int dtok, const float mref) {
    int lane = lane_; asm volatile("" : "+v"(lane));
    const int col = lane & 31, hi = lane >> 5, hh = col >> 3, tok = col & 7, t0 = 64 * j + 8 * w, t = t0 + tok, h = 4 * g + hh;
    const size_t row = (size_t)b * T + t;
    const float sl2 = __builtin_amdgcn_exp2f(-(float)(h + 1)) * LOG2E;
    const float gt0 = P.GATES[row * 24 + h * 3], gt1 = P.GATES[row * 24 + h * 3 + 1], gt2 = P.GATES[row * 24 + h * 3 + 2];
    const size_t hb = (size_t)(b * 2 + g);
    const bf16* Kc = P.KCN + hb * 512 * 64; const bf16* Vc = P.VCC + hb * 512 * 64;
    const bf16* Ks = P.KS + hb * T * 64; const bf16* Vs = P.VS + hb * T * 64; const bf16* Kw = P.KW + hb * T * 64; const bf16* Vw = P.VW + hb * T * 64;
    LAS char* wl = lds + AL_WAVE + w * AL_WSTRIDE; LAS float* imp = (LAS float*)wl;
    LAS const char* qf = wl + 8192 + lane * 16;
#pragma unroll
    for (int d0 = 0; d0 < 4; ++d0) *(LAS bf16x8*)(wl + 8192 + d0 * 1024 + lane * 16) = *(const bf16x8*)(P.Q + row * 512 + h * 64 + 16 * d0 + 8 * hi);
    const int vlane = ((lane >> 4) & 1) * 32 + (lane & 3) * 8 + (4 * hi + ((lane & 15) >> 2)) * 64;
#pragma unroll
    for (int i = 0; i < 4; ++i) ((LAS u32x4*)wl)[i * 64 + lane] = (u32x4){0u, 0u, 0u, 0u};
    const int ncv = ((64 * j + 63 - 31) >> 4) + 1, ntc = (DBG == 6) ? 0 : (ncv + 63) >> 6;
    float m = FIX ? mref : -1e30f, l = 0.f;
    int i0 = 0, n_neg = -1;
    if (dtok > 0) { const int c_neg = (64 * j - 31 - dtok) >> 4; if (c_neg >= 63) i0 = ((c_neg - 63) >> 6) + 1; if (i0 > ntc - 1) i0 = ntc > 0 ? ntc - 1 : 0; n_neg = (64 * j - 63 - dtok) >> 6; }
    SEQ_SYNC();
    if (i0 < ntc) dma_k(Kc + i0 * 4096, lds + AL_K, w, lane);
    if (i0 + 1 < ntc) dma_k(Kc + (i0 + 1) * 4096, lds + AL_K + 8192, w, lane);
    for (int i = i0, ib = 0; i < ntc; ++i, ib = (ib == 2 ? 0 : ib + 1)) {
        TILE_SYNC(i + 1 < ntc, 1);
        if (i + 2 < ntc) dma_k(Kc + (i + 2) * 4096, lds + AL_K + (ib == 0 ? 2 : ib - 1) * 8192, w, lane);
        int db0 = t - 31 - 16 * (64 * i + 4 * hi); asm volatile("" : "+v"(db0)); const int db1 = db0 - 512;
        f32x16 p0, p1;
        { const float mr = FIX ? m : 0.f; f32x16 c0, c1; mk_cinit(c0, -sl2 * (float)db0 - mr, sl2 * 16.f); mk_cinit(c1, -sl2 * (float)db1 - mr, sl2 * 16.f); qk_lds(lds + AL_K + ib * 8192, qf, c0, c1, p0, p1, col, hi); }
        if (i + 2 >= ntc) { tile_mask<false, 16>(p0, db0); tile_mask<false, 16>(p1, db1); }
        if (FIX) {
#pragma unroll
            for (int r = 0; r < 16; ++r) { p0[r] = __builtin_amdgcn_exp2f(p0[r]); p1[r] = __builtin_amdgcn_exp2f(p1[r]); }
            __builtin_amdgcn_sched_barrier(0);
            float r0 = add_(p0[0], p1[0]), r1 = add_(p0[1], p1[1]), r2 = add_(p0[2], p1[2]), r3 = add_(p0[3], p1[3]);
#pragma unroll
            for (int r = 4; r < 16; r += 4) { r0 = add_(add_(r0, p0[r]), p1[r]); r1 = add_(add_(r1, p0[r + 1]), p1[r + 1]); r2 = add_(add_(r2, p0[r + 2]), p1[r + 2]); r3 = add_(add_(r3, p0[r + 3]), p1[r + 3]); }
            l += sum_x32(add_(add_(r0, r1), add_(r2, r3)));
        } else {
        const float mt = tile_max(p0, p1), mn = fmaxf(m, mt);
        float rs = 0.f;
#pragma unroll
        for (int r = 0; r < 16; ++r) rs += __builtin_amdgcn_exp2f(p0[r] - mn) + __builtin_amdgcn_exp2f(p1[r] - mn);
        l = l * __builtin_amdgcn_exp2f(m - mn) + sum_x32(rs); m = mn;
        }
    }
    const float lil = l > 0.f ? -__builtin_amdgcn_logf(l) : -INFINITY;
    f32x16 oc0 = {}, oc1 = {};
    SEQ_SYNC();
    if (i0 < ntc) { dma_k(Kc + i0 * 4096, lds + AL_K, w, lane); dma_v(Vc + i0 * 4096, lds + AL_V, w, lane); }
    if (i0 + 1 < ntc) { dma_k(Kc + (i0 + 1) * 4096, lds + AL_K + 8192, w, lane); dma_v(Vc + (i0 + 1) * 4096, lds + AL_V + 8192, w, lane); }
    {
        u32x4 pw[4];
        int ik = 0, iv = 0;
        for (int i = i0; i < ntc; ++i) {
            TILE_SYNC(i + 1 < ntc, 2);
            if (i + 2 < ntc) { dma_k(Kc + (i + 2) * 4096, lds + AL_K + (ik == 0 ? 2 : ik - 1) * 8192, w, lane); dma_v(Vc + (i + 2) * 4096, lds + AL_V + ((iv + 2) & 3) * 8192, w, lane); }
            int db0 = t - 31 - 16 * (64 * i + 4 * hi); asm volatile("" : "+v"(db0)); const int db1 = db0 - 512;
            f32x16 p0, p1;
            { f32x16 c0, c1; mk_cinit(c0, -sl2 * (float)db0 - m + lil, sl2 * 16.f); mk_cinit(c1, -sl2 * (float)db1 - m + lil, sl2 * 16.f); qk_lds(lds + AL_K + ik * 8192, qf, c0, c1, p0, p1, col, hi); }
            if (i + 2 >= ntc) { tile_mask<false, 16>(p0, db0); tile_mask<false, 16>(p1, db1); }
#pragma unroll
            for (int r = 0; r < 16; ++r) { p0[r] = __builtin_amdgcn_exp2f(p0[r]); p1[r] = __builtin_amdgcn_exp2f(p1[r]); }
            LAS float* impb = imp + (16 * i + hi) * 8 + tok; asm volatile("" : "+v"(impb));
#pragma unroll
            for (int kb = 0; kb < 2; ++kb)
#pragma unroll
                for (int a = 0; a < 4; ++a) { const int r0 = 4 * a;
                    const float x0 = kb ? p1[r0] : p0[r0], x1 = kb ? p1[r0 + 1] : p0[r0 + 1], x2 = kb ? p1[r0 + 2] : p0[r0 + 2], x3 = kb ? p1[r0 + 3] : p0[r0 + 3];
                    float mv = (x0 + x1) + (x2 + 0.5f * x3), sv = 0.5f * x3;
                    mv = sum_x16(sum_x8(mv)); sv = sum_x16(sum_x8(sv));
                    const int n = 16 * i + 8 * kb + 2 * a + hi;
                    if (hh == 0) { asm volatile("ds_add_f32 %0, %1 offset:%c2" :: "v"((unsigned)(__SIZE_TYPE__)impb), "v"(mv), "i"((8 * kb + 2 * a) * 32) : "memory");
                        if (n < 127) asm volatile("ds_add_f32 %0, %1 offset:%c2" :: "v"((unsigned)(__SIZE_TYPE__)impb), "v"(sv), "i"((8 * kb + 2 * a + 1) * 32) : "memory"); } }
            pack_p(p0, p1, pw);
            pv_tile(lds + AL_V + iv * 8192 + vlane, pw, oc0, oc1);
            ik = (ik == 2 ? 0 : ik + 1); iv = (iv + 1) & 3;
        }
    }
    const int nfirst = (DBG == 6) ? j + 1 : (j >= 8 ? j - 8 : 0);
    SEQ_SYNC();
    if (DBG != 6) { dma_k(Kw + (size_t)j * 4096, lds + AL_K, w, lane); dma_v(Vw + (size_t)j * 4096, lds + AL_V, w, lane);
        if (j > nfirst) { dma_k(Kw + (size_t)(j - 1) * 4096, lds + AL_K + 8192, w, lane); dma_v(Vw + (size_t)(j - 1) * 4096, lds + AL_V + 8192, w, lane); } }
    unsigned mwl[4]; unsigned long long ulo, uhi;
    if (j < 16 || DBG == 5 || DBG == 6) {
        mwl[0] = (2u << (j & 15)) - 1u; mwl[1] = 0u; mwl[2] = 0u; mwl[3] = 0u; ulo = (DBG == 6) ? 0ull : (j < 16 ? (2ull << j) - 1ull : 0x3ffffffull); uhi = (DBG == 5 && j >= 64) ? (1ull << (j - 64)) : 0ull; if (DBG == 5 && j >= 16 && j < 64) ulo |= 1ull << j;
    } else {
        const int tk = lane >> 3, sub = lane & 7;
        unsigned keys[16];
#pragma unroll
        for (int i = 0; i < 16; ++i) { const int n = i * 8 + sub; const float v = imp[n * 8 + tk];
            keys[i] = (n < j && n != 0) ? ((__float_as_uint(v) & ~255u) | (unsigned)(255 - n)) : 0u; }
        unsigned mw[4] = {1u, 0u, 0u, 0u};
#pragma unroll
        for (int q = 0; q < 4; ++q) mw[q] |= ((j >> 5) == q) ? (1u << (j & 31)) : 0u;
        for (int round = 0; round < 14; ++round) {
            unsigned mx = keys[0];
#pragma unroll
            for (int i = 1; i < 16; ++i) mx = mx > keys[i] ? mx : keys[i];
            unsigned o;
            o = (unsigned)__builtin_amdgcn_update_dpp(0, (int)mx, 0xB1, 0xf, 0xf, false); mx = mx > o ? mx : o;
            o = (unsigned)__builtin_amdgcn_update_dpp(0, (int)mx, 0x4E, 0xf, 0xf, false); mx = mx > o ? mx : o;
            o = (unsigned)__builtin_amdgcn_update_dpp(0, (int)mx, 0x141, 0xf, 0xf, false); mx = mx > o ? mx : o;
            if (mx != 0u) { const int n = 255 - (int)(mx & 255u);
#pragma unroll
                for (int q = 0; q < 4; ++q) mw[q] |= ((n >> 5) == q) ? (1u << (n & 31)) : 0u;
#pragma unroll
                for (int i = 0; i < 16; ++i) keys[i] = keys[i] == mx ? 0u : keys[i]; }
        }
        LAS unsigned* xch = (LAS unsigned*)(lds + AL_XCH);
#pragma unroll
        for (int q = 0; q < 4; ++q) { mwl[q] = __shfl(mw[q], (lane & 7) * 8);
            unsigned u = mw[q]; u |= __shfl_xor(u, 8); u |= __shfl_xor(u, 16); u |= __shfl_xor(u, 32); if (lane == 0) xch[w * 4 + q] = u; }
        __syncthreads();
        unsigned u = xch[lane & 31]; u |= __shfl_xor(u, 4); u |= __shfl_xor(u, 8); u |= __shfl_xor(u, 16);
        const unsigned u0 = __builtin_amdgcn_readlane(u, 0), u1 = __builtin_amdgcn_readlane(u, 1), u2 = __builtin_amdgcn_readlane(u, 2), u3 = __builtin_amdgcn_readlane(u, 3);
        ulo = ((unsigned long long)u1 << 32) | u0; uhi = ((unsigned long long)u3 << 32) | u2;
    }
    LAS u32x4* acs = (LAS u32x4*)(wl + lane * 64);
#pragma unroll
    for (int a = 0; a < 2; ++a) {
        acs[a] = (u32x4){pk2(oc0[8 * a] * gt0, oc0[8 * a + 1] * gt0), pk2(oc0[8 * a + 2] * gt0, oc0[8 * a + 3] * gt0), pk2(oc0[8 * a + 4] * gt0, oc0[8 * a + 5] * gt0), pk2(oc0[8 * a + 6] * gt0, oc0[8 * a + 7] * gt0)};
        acs[2 + a] = (u32x4){pk2(oc1[8 * a] * gt0, oc1[8 * a + 1] * gt0), pk2(oc1[8 * a + 2] * gt0, oc1[8 * a + 3] * gt0), pk2(oc1[8 * a + 4] * gt0, oc1[8 * a + 5] * gt0), pk2(oc1[8 * a + 6] * gt0, oc1[8 * a + 7] * gt0)};
    }
    {
        float mw_ = FIX ? mref : 0.f, lw = 0.f; f32x16 o0 = {}, o1 = {};
        u32x4 pw[4]; int ik = 0, iv = 0;
        for (int n = j; n >= nfirst; --n) {
            TILE_SYNC(n > nfirst, 2);
            if (n - 2 >= nfirst) { dma_k(Kw + (size_t)(n - 2) * 4096, lds + AL_K + (ik == 0 ? 2 : ik - 1) * 8192, w, lane); dma_v(Vw + (size_t)(n - 2) * 4096, lds + AL_V + ((iv + 2) & 3) * 8192, w, lane); }
            online_A<true, DBG, FIX>(lds + AL_K + ik * 8192, 64 * n, true, (n == j) || (n + 8 <= j), t, sl2, qf, mw_, lw, o0, o1, pw, col, hi);
            if (DBG != 8) pv_tile(lds + AL_V + iv * 8192 + vlane, pw, o0, o1); else { o0[0] += __uint_as_float(pw[0].x); }
            ik = (ik == 2 ? 0 : ik + 1); iv = (iv + 1) & 3;
        }
        const float sc = (DBG == 6) ? 0.f : gt2 / lw;
#pragma unroll
        for (int a = 0; a < 2; ++a) {
            const u32x4 q0 = acs[a], q1 = acs[2 + a];
            acs[a] = (u32x4){pk2(bflo(q0.x) + o0[8 * a] * sc, bfhi(q0.x) + o0[8 * a + 1] * sc), pk2(bflo(q0.y) + o0[8 * a + 2] * sc, bfhi(q0.y) + o0[8 * a + 3] * sc),
                             pk2(bflo(q0.z) + o0[8 * a + 4] * sc, bfhi(q0.z) + o0[8 * a + 5] * sc), pk2(bflo(q0.w) + o0[8 * a + 6] * sc, bfhi(q0.w) + o0[8 * a + 7] * sc)};
            acs[2 + a] = (u32x4){pk2(bflo(q1.x) + o1[8 * a] * sc, bfhi(q1.x) + o1[8 * a + 1] * sc), pk2(bflo(q1.y) + o1[8 * a + 2] * sc, bfhi(q1.y) + o1[8 * a + 3] * sc),
                                 pk2(bflo(q1.z) + o1[8 * a + 4] * sc, bfhi(q1.z) + o1[8 * a + 5] * sc), pk2(bflo(q1.w) + o1[8 * a + 6] * sc, bfhi(q1.w) + o1[8 * a + 7] * sc)};
        }
    }
    {
        float ms = FIX ? mref : 0.f, ls = 0.f; f32x16 o0 = {}, o1 = {};
        if (n_neg >= 0) { if (n_neg >= 63) { ulo = 0ull; if (n_neg >= 64) uhi &= ~((2ull << (n_neg - 64)) - 1ull); } else ulo &= ~((2ull << n_neg) - 1ull); }
        int cur = prev_bit(ulo, uhi, 128), ik = 0, iv = 0;
        int nxt = cur >= 0 ? prev_bit(ulo, uhi, cur) : -1;
        u32x4 pw[4] = {}; bool first = true;
        SEQ_SYNC();
        if (cur >= 0) { dma_k(Ks + (size_t)cur * 4096, lds + AL_K, w, lane); dma_v(Vs + (size_t)cur * 4096, lds + AL_V, w, lane); }
        if (nxt >= 0) { dma_k(Ks + (size_t)nxt * 4096, lds + AL_K + 8192, w, lane); dma_v(Vs + (size_t)nxt * 4096, lds + AL_V + 8192, w, lane); }
        while (cur >= 0) {
            const int nx2 = nxt >= 0 ? prev_bit(ulo, uhi, nxt) : -1;
            TILE_SYNC(nxt >= 0, 2);
            if (nx2 >= 0) { dma_k(Ks + (size_t)nx2 * 4096, lds + AL_K + (ik == 0 ? 2 : ik - 1) * 8192, w, lane); dma_v(Vs + (size_t)nx2 * 4096, lds + AL_V + ((iv + 2) & 3) * 8192, w, lane); }
            const unsigned lword = (cur < 32) ? mwl[0] : (cur < 64) ? mwl[1] : (cur < 96) ? mwl[2] : mwl[3];
            const bool selb = (lword >> (cur & 31)) & 1u;
            online_A<false, DBG, FIX>(lds + AL_K + ik * 8192, 64 * cur, selb, cur == j, t, sl2, qf, ms, ls, o0, o1, pw, col, hi);
            if (DBG != 8) pv_tile(lds + AL_V + iv * 8192 + vlane, pw, o0, o1); else { o0[0] += __uint_as_float(pw[0].x); }
            cur = nxt; nxt = nx2; ik = (ik == 2 ? 0 : ik + 1); iv = (iv + 1) & 3; first = false;
        }
        const float sc = (DBG == 6) ? 0.f : gt1 / ls;
#pragma unroll
        for (int a = 0; a < 2; ++a) {
            const u32x4 q0 = acs[a], q1 = acs[2 + a];
            ot0[8 * a] = bflo(q0.x) + o0[8 * a] * sc; ot0[8 * a + 1] = bfhi(q0.x) + o0[8 * a + 1] * sc; ot0[8 * a + 2] = bflo(q0.y) + o0[8 * a + 2] * sc; ot0[8 * a + 3] = bfhi(q0.y) + o0[8 * a + 3] * sc;
            ot0[8 * a + 4] = bflo(q0.z) + o0[8 * a + 4] * sc; ot0[8 * a + 5] = bfhi(q0.z) + o0[8 * a + 5] * sc; ot0[8 * a + 6] = bflo(q0.w) + o0[8 * a + 6] * sc; ot0[8 * a + 7] = bfhi(q0.w) + o0[8 * a + 7] * sc;
            ot1[8 * a] = bflo(q1.x) + o1[8 * a] * sc; ot1[8 * a + 1] = bfhi(q1.x) + o1[8 * a + 1] * sc; ot1[8 * a + 2] = bflo(q1.y) + o1[8 * a + 2] * sc; ot1[8 * a + 3] = bfhi(q1.y) + o1[8 * a + 3] * sc;
            ot1[8 * a + 4] = bflo(q1.z) + o1[8 * a + 4] * sc; ot1[8 * a + 5] = bfhi(q1.z) + o1[8 * a + 5] * sc; ot1[8 * a + 6] = bflo(q1.w) + o1[8 * a + 6] * sc; ot1[8 * a + 7] = bfhi(q1.w) + o1[8 * a + 7] * sc;
        }
    }
}
template <int DBG> DI void attn_phase(Frame& F, const int dbg) {
    AttnP P; P.Q = (const bf16*)(F.ws + WS_Q); P.KCN = (const bf16*)(F.ws + WS_KCN); P.VCC = (const bf16*)(F.ws + WS_VCC);
    P.KS = (const bf16*)(F.ws + WS_KS); P.VS = (const bf16*)(F.ws + WS_VS); P.KW = (const bf16*)(F.ws + WS_KW); P.VW = (const bf16*)(F.ws + WS_VW);
    P.GATES = (const float*)(F.ws + WS_GATES); P.MX = (bf16*)(F.ws + ((dbg || DBG >= 5) ? WS_O2 : WS_MIXED));
    const int lane = lane_id(), w = F.wave;
    LAS char* lds = (LAS char*)F.lds;
    int dtok0; float mref;
    { const float* qg = fin(F, 3); const float* kg = fin(F, 4);
      float a = fabsf(qg[lane]), c = fmaxf(fabsf(kg[lane]), fabsf(kg[64 + lane]));
#pragma unroll
      for (int o = 1; o < 64; o <<= 1) { a = fmaxf(a, __shfl_xor(a, o)); c = fmaxf(c, __shfl_xor(c, o)); }
      const float Bq = 8.0f * LOG2E * a * c;
      dtok0 = __builtin_amdgcn_readfirstlane((int)((2.0f * Bq + 39.0f) / (0.0625f * LOG2E)) + 1);
      float c3 = fmaxf(c, fabsf(kg[128 + lane]));
#pragma unroll
      for (int o = 1; o < 64; o <<= 1) c3 = fmaxf(c3, __shfl_xor(c3, o));
      mref = __uint_as_float(__builtin_amdgcn_readfirstlane(__float_as_uint(8.0f * LOG2E * a * c3 * 1.02f + 1.0f))); }
    const bool fixref = mref <= 40.0f;
    for (int u = F.vcu; u < M / 64; u += F.G) {
        const int b = u >> 7, j = u & 127;
        const int col = lane & 31, hi = lane >> 5, hh = col >> 3, tok = col & 7;
        LAS u32x4* st = (LAS u32x4*)(lds + AL_WAVE + w * AL_WSTRIDE + 4096 + lane * 64);
        float ssq = 0.f;
        {
            f32x16 oa0, oa1;
            if (fixref) attn_group<DBG, true>(P, lds, 0, b, j, w, lane, oa0, oa1, dbg, dtok0, mref); else attn_group<DBG, false>(P, lds, 0, b, j, w, lane, oa0, oa1, dbg, dtok0, 0.f);
#pragma unroll
            for (int r = 0; r < 16; ++r) ssq += oa0[r] * oa0[r] + oa1[r] * oa1[r];
#pragma unroll
            for (int a = 0; a < 2; ++a) {
                st[a] = (u32x4){pk2(oa0[8 * a], oa0[8 * a + 1]), pk2(oa0[8 * a + 2], oa0[8 * a + 3]), pk2(oa0[8 * a + 4], oa0[8 * a + 5]), pk2(oa0[8 * a + 6], oa0[8 * a + 7])};
                st[2 + a] = (u32x4){pk2(oa1[8 * a], oa1[8 * a + 1]), pk2(oa1[8 * a + 2], oa1[8 * a + 3]), pk2(oa1[8 * a + 4], oa1[8 * a + 5]), pk2(oa1[8 * a + 6], oa1[8 * a + 7])};
            }
        }
        f32x16 ob0, ob1;
        if (fixref) attn_group<DBG, true>(P, lds, 1, b, j, w, lane, ob0, ob1, dbg, 0, mref); else attn_group<DBG, false>(P, lds, 1, b, j, w, lane, ob0, ob1, dbg, 0, 0.f);
#pragma unroll
        for (int r = 0; r < 16; ++r) ssq += ob0[r] * ob0[r] + ob1[r] * ob1[r];
        ssq += __shfl_xor(ssq, 32); ssq += __shfl_xor(ssq, 8); ssq += __shfl_xor(ssq, 16);
        const float rinv = __builtin_amdgcn_rsqf(ssq * (1.0f / 512.0f) + EPS);
        bf16* mp = P.MX + ((size_t)b * T + 64 * j + 8 * w + tok) * 1024 + hh * 64 + 4 * hi;
#pragma unroll
        for (int a = 0; a < 2; ++a) {
            const u32x4 q0 = st[a], q1 = st[2 + a];
            u32x2 wv;
            wv.x = pk2(bflo(q0.x) * rinv, bfhi(q0.x) * rinv); wv.y = pk2(bflo(q0.y) * rinv, bfhi(q0.y) * rinv); *(u32x2*)(mp + 8 * (2 * a)) = wv;
            wv.x = pk2(bflo(q0.z) * rinv, bfhi(q0.z) * rinv); wv.y = pk2(bflo(q0.w) * rinv, bfhi(q0.w) * rinv); *(u32x2*)(mp + 8 * (2 * a + 1)) = wv;
            wv.x = pk2(bflo(q1.x) * rinv, bfhi(q1.x) * rinv); wv.y = pk2(bflo(q1.y) * rinv, bfhi(q1.y) * rinv); *(u32x2*)(mp + 32 + 8 * (2 * a)) = wv;
            wv.x = pk2(bflo(q1.z) * rinv, bfhi(q1.z) * rinv); wv.y = pk2(bflo(q1.w) * rinv, bfhi(q1.w) * rinv); *(u32x2*)(mp + 32 + 8 * (2 * a + 1)) = wv;
        }
#pragma unroll
        for (int a = 0; a < 4; ++a) {
            u32x2 wv;
            wv.x = pk2(ob0[4 * a] * rinv, ob0[4 * a + 1] * rinv); wv.y = pk2(ob0[4 * a + 2] * rinv, ob0[4 * a + 3] * rinv); *(u32x2*)(mp + 256 + 8 * a) = wv;
            wv.x = pk2(ob1[4 * a] * rinv, ob1[4 * a + 1] * rinv); wv.y = pk2(ob1[4 * a + 2] * rinv, ob1[4 * a + 3] * rinv); *(u32x2*)(mp + 256 + 32 + 8 * a) = wv;
        }
    }
    __syncthreads();
}
DI void attn_tail_convert(Frame& F) {
    LAS char* tile = (LAS char*)F.lds + AL_WAVE + F.wave * AL_WSTRIDE;
    if (F.G == 256) { const int b = F.vcu >> 7, j = F.vcu & 127;
        if (j < 27) { const int cnt = j < 8 ? 10 : j < 16 ? 7 : j < 22 ? 4 : 2, pre = j < 8 ? 10 * j : j < 16 ? 80 + 7 * (j - 8) : j < 22 ? 136 + 4 * (j - 16) : 160 + 2 * (j - 22);
            const int lo = CV_A3 + (b * 170 + pre) * NWAVES, hi = lo + cnt * NWAVES, end = CV_A3 + CV_N4;
            p0_convert(F, tile, lo, hi < end ? hi : end, F.wave, NWAVES); } }
    else p0_convert(F, tile, CV_A3, CV_A3 + CV_N4, F.vcu * NWAVES + F.wave, F.G * NWAVES);
}

DI float xch1(float v)  { return __int_as_float(__builtin_amdgcn_update_dpp(0, __float_as_int(v), 0xB1, 0xf, 0xf, false)); }
DI float xch2(float v)  { return __int_as_float(__builtin_amdgcn_update_dpp(0, __float_as_int(v), 0x4E, 0xf, 0xf, false)); }
DI float xch4(float v)  { const int t = __builtin_amdgcn_update_dpp(0, __float_as_int(v), 0x141, 0xf, 0xf, false); return __int_as_float(__builtin_amdgcn_update_dpp(0, t, 0x1B, 0xf, 0xf, false)); }
DI float xch8(float v)  { return __int_as_float(__builtin_amdgcn_update_dpp(0, __float_as_int(v), 0x128, 0xf, 0xf, false)); }
DI float xch16(float v, int lane) { const auto r = __builtin_amdgcn_permlane16_swap(__float_as_uint(v), __float_as_uint(v), false, false); return __uint_as_float((lane & 16) ? r[0] : r[1]); }
DI float xch32(float v, int lane) { const auto r = __builtin_amdgcn_permlane32_swap(__float_as_uint(v), __float_as_uint(v), false, false); return __uint_as_float((lane & 32) ? r[0] : r[1]); }
constexpr int RT_WH = 0, RT_WL = 65536, RT_PART = 131072  , RT_AUX = 156672, RT_SSQ = RT_AUX + 2560;
static_assert(RT_PART + 3 * 64 * 33 * 4 <= RT_AUX && RT_SSQ + 1024 <= MISC_OFF, "router LDS map");
template <int DBG> DI void route_phase(Frame& F) {
    const int lane = lane_id(), w = F.wave, tid = w * 64 + lane, col = lane & 31, hi = lane >> 5, ct = w & 1, kq = w >> 1;
    LAS char* lds = (LAS char*)F.lds;
    LAS int* hist = (LAS int*)(lds + RT_AUX); LAS int* base = hist + 32; LAS int* tmp = hist + 64; LAS float* tmpg = (LAS float*)(hist + 64 + 256); LAS float* tmpr = (LAS float*)(hist + 64 + 512);
    LAS float* part = (LAS float*)(lds + RT_PART); LAS float* ssqp = (LAS float*)(lds + RT_SSQ);
    const float* wr = fin(F, 17); const float* g2 = fin(F, 16); const float* br = fin(F, 18);
    for (int it = tid; it < 64 * 64; it += NWAVES * 64) {
        const int ks = it >> 6, ln = it & 63, e = ln & 31, k0 = 16 * ks + 8 * (ln >> 5);
        float v[8];
#pragma unroll
        for (int j = 0; j < 8; ++j) v[j] = wr[(k0 + j) * 32 + e] * g2[k0 + j];
        u32x4 h, lo;
        h.x = pk2(v[0], v[1]); h.y = pk2(v[2], v[3]); h.z = pk2(v[4], v[5]); h.w = pk2(v[6], v[7]);
        lo.x = pk2(v[0] - bflo(h.x), v[1] - bfhi(h.x)); lo.y = pk2(v[2] - bflo(h.y), v[3] - bfhi(h.y)); lo.z = pk2(v[4] - bflo(h.z), v[5] - bfhi(h.z)); lo.w = pk2(v[6] - bflo(h.w), v[7] - bfhi(h.w));
        *(LAS u32x4*)(lds + RT_WH + it * 16) = h; *(LAS u32x4*)(lds + RT_WL + it * 16) = lo;
    }
    int* list = (int*)(F.ws + WS_LIST); int* tokinfo = (int*)(F.ws + WS_TOKINFO); float* tgate = (float*)(F.ws + WS_TGATE);
    for (int blk = F.vcu; blk < M / 64; blk += F.G) {
        if (tid < 32) hist[tid] = 0;
        __syncthreads();
        const int tok = blk * 64 + 32 * ct + col;
        const bf16* xr = (const bf16*)(F.ws + WS_X1H) + (size_t)tok * D + 256 * kq + 8 * hi;
        f32x16 acc = {};
        float ssq = 0.f;
#pragma unroll 4
        for (int ks = 0; ks < 16; ++ks) {
            const u32x4 xq = *(const u32x4*)(xr + 16 * ks);
            { const float a0 = bflo(xq.x), a1 = bfhi(xq.x), a2 = bflo(xq.y), a3 = bfhi(xq.y), a4 = bflo(xq.z), a5 = bfhi(xq.z), a6 = bflo(xq.w), a7 = bfhi(xq.w);
              ssq += (a0 * a0 + a1 * a1) + (a2 * a2 + a3 * a3) + (a4 * a4 + a5 * a5) + (a6 * a6 + a7 * a7); }
            const int fo = ((16 * kq + ks) * 64 + lane) * 16;
            const bf16x8 wh = *(const LAS bf16x8*)(lds + RT_WH + fo), wl = *(const LAS bf16x8*)(lds + RT_WL + fo);
            const bf16x8 bx = __builtin_bit_cast(bf16x8, xq);
            acc = MFMA32(wh, bx, acc); acc = MFMA32(wl, bx, acc);
        }
        ssq += xch32(ssq, lane);
        if (hi == 0) ssqp[kq * 64 + 32 * ct + col] = ssq;
        if (kq > 0) {
#pragma unroll
            for (int r = 0; r < 16; ++r) part[((kq - 1) * 64 + 32 * ct + col) * 33 + (r & 3) + 8 * (r >> 2) + 4 * hi] = acc[r];
        }
        __syncthreads();
        if (kq == 0) {
            const int tl = 32 * ct + col;
            const float rinv = __builtin_amdgcn_rsqf((ssqp[tl] + ssqp[64 + tl] + ssqp[128 + tl] + ssqp[192 + tl]) * (1.f / D) + EPS);
            unsigned keys[16]; float lg[16];
#pragma unroll
            for (int r = 0; r < 16; ++r) { const int e = (r & 3) + 8 * (r >> 2) + 4 * hi;
                const float s = acc[r] + part[tl * 33 + e] + part[(64 + tl) * 33 + e] + part[(128 + tl) * 33 + e];
                lg[r] = s * rinv + br[e];
                unsigned ub = __float_as_uint(lg[r]); ub = (ub & 0x80000000u) ? ~ub : (ub | 0x80000000u);
                keys[r] = (ub & ~31u) | (unsigned)(31 - e); }
            int ek[4]; float vk[4];
#pragma unroll
            for (int k = 0; k < 4; ++k) {
                unsigned mx = keys[0];
#pragma unroll
                for (int r = 1; r < 16; ++r) mx = mx > keys[r] ? mx : keys[r];
                const unsigned o = __float_as_uint(xch32(__uint_as_float(mx), lane)); mx = mx > o ? mx : o;
                ek[k] = 31 - (int)(mx & 31u);
                float v = 0.f;
#pragma unroll
                for (int r = 0; r < 16; ++r) { if (keys[r] == mx) { v = lg[r]; keys[r] = 0u; } }
                v += xch32(v, lane);
                vk[k] = v;
            }
            const float e1 = __expf(vk[1] - vk[0]), e2 = __expf(vk[2] - vk[0]), e3 = __expf(vk[3] - vk[0]);
            const float inv = 1.0f / (1.0f + e1 + e2 + e3);
            if (hi == 0) {
#pragma unroll
                for (int k = 0; k < 4; ++k) {
                    const float gg = (k == 0 ? 1.0f : k == 1 ? e1 : k == 2 ? e2 : e3) * inv;
                    const int rank = __hip_atomic_fetch_add(&hist[ek[k]], 1, __ATOMIC_RELAXED, __HIP_MEMORY_SCOPE_WORKGROUP);
                    tmp[tl * 4 + k] = (ek[k] << 16) | rank; tmpg[tl * 4 + k] = gg;
                }
                tmpr[tl] = rinv;
            }
        }
        __syncthreads();
        if (tid < 32) base[tid] = DBG ? 0 : (int)__hip_atomic_fetch_add((unsigned*)(F.ctl + CW_CNT + tid), (unsigned)hist[tid], __ATOMIC_RELAXED, __HIP_MEMORY_SCOPE_AGENT);
        __syncthreads();
        if (tid < 256 && !DBG) {
            const int rowi = tid >> 2, k = tid & 3, pk = tmp[tid], ee = pk >> 16, p = base[ee] + (pk & 0xffff), tk = blk * 64 + rowi;
            list[((size_t)ee * M + p) * 2] = tk; list[((size_t)ee * M + p) * 2 + 1] = __float_as_int(tmpr[rowi]);
            tokinfo[tk * 4 + k] = (ee << 16) | p; tgate[tk * 4 + k] = tmpg[tid];
        }
        __syncthreads();
    }
}
DI void moe_tables(Frame& F, LAS int*& tstart, LAS int*& ecnt) {
    const int tid = F.wave * 64 + lane_id();
    tstart = (LAS int*)(F.lds + AUX_OFF + 8192); ecnt = tstart + 64;
    if (tid == 0) { int a = 0; for (int e = 0; e < 32; ++e) { const int c = (int)__hip_atomic_load((unsigned*)(F.ctl + CW_CNT + e), __ATOMIC_RELAXED, __HIP_MEMORY_SCOPE_AGENT); tstart[e] = a; ecnt[e] = c; a += (c + 255) >> 8; } tstart[32] = a; }
    __syncthreads();
}
template <int DBG> DI void final_phase(Frame& F, const LAS int* tstart) {
    const int gw = F.vcu * NWAVES + F.wave, NGW = F.G * NWAVES, lane = lane_id();
    const int* tokinfo = (const int*)(F.ws + WS_TOKINFO); const float* tgate = (const float*)(F.ws + WS_TGATE); const unsigned char* O2 = F.ws + WS_O2;
    for (int tok = gw; tok < M; tok += NGW) {
        f32x4* op = (f32x4*)(F.out + (size_t)tok * D) + lane;
        const u32x2* xp = (const u32x2*)(F.ws + WS_X1H + (size_t)tok * D * 2) + lane;
        f32x4 a[4];
#pragma unroll
        for (int j = 0; j < 4; ++j) { const u32x2 h = __builtin_nontemporal_load(xp + 64 * j); a[j].x = bflo(h.x); a[j].y = bfhi(h.x); a[j].z = bflo(h.y); a[j].w = bfhi(h.y); }
#pragma unroll
        for (int k = 0; k < 4; ++k) {
            const int info = tokinfo[tok * 4 + k]; const float gk = tgate[tok * 4 + k] * O2SCALE_INV;
            const size_t rowk = (size_t)tstart[info >> 16] * 256 + (info & 0xffff);
            const unsigned* o2 = (const unsigned*)(O2 + rowk * 1024) + lane;
#pragma unroll
            for (int j = 0; j < 4; ++j) { const unsigned w = __builtin_nontemporal_load(o2 + 64 * j);
                a[j].x += gk * __builtin_amdgcn_cvt_f32_fp8(w, 0); a[j].y += gk * __builtin_amdgcn_cvt_f32_fp8(w, 1); a[j].z += gk * __builtin_amdgcn_cvt_f32_fp8(w, 2); a[j].w += gk * __builtin_amdgcn_cvt_f32_fp8(w, 3); }
        }
        f32x4* wp = DBG ? (f32x4*)((float*)(F.ws + WS_H) + (size_t)(tok & 8191) * D) + lane : op;
#pragma unroll
        for (int j = 0; j < 4; ++j) __builtin_nontemporal_store(a[j], wp + 64 * j);
    }
}

#ifndef MK_SPLIT
#define MK_SPLIT 0
#endif
constexpr int NPHASE = 10;
struct Args { const float* in[23]; float* out; unsigned char* ws; int ph_lo, ph_hi, dbg, pad; };
template <int DBG> __global__ void __launch_bounds__(NWAVES * 64, 2) mk_fwd_t(Args args) {
    extern __shared__ __attribute__((aligned(16))) unsigned char lds[];
    Frame F;
    F.lds = (LAS unsigned char*)lds; F.MISC = (volatile LAS unsigned*)(F.lds + MISC_OFF);
    F.wave = __builtin_amdgcn_readfirstlane((int)threadIdx.x >> 6);
    F.G = gridDim.x; { const int bx = blockIdx.x; F.vcu = (F.G % 8 == 0) ? (bx % 8) * (F.G / 8) + bx / 8 : bx; }
    F.ka = (kptr_t)__builtin_amdgcn_kernarg_segment_ptr();
    F.out = args.out; F.ws = args.ws; F.ctl = (gu32*)(args.ws + WS_CTL);
    unsigned char* ws = args.ws;
    { const int tid0 = threadIdx.x; if (tid0 < 128) ((LAS unsigned*)(F.lds + MISC_OFF))[tid0] = 0u; }
    __syncthreads();
    XcdBarrier bar; bar.bar = (unsigned*)(F.ctl + CW_BAR); bar.x = 0; bar.st = nullptr;
    if (!MK_SPLIT) bar = xcd_barrier_post((unsigned*)(F.ctl + CW_BAR), F.MISC + 8, F.wave == 0 && lane_id() == 0);
    const int lo = args.ph_lo, hi = args.ph_hi;
#ifndef ONLY_PHASE
#define ONLY_PHASE -1
#endif
#ifndef MK_ATT_DBG
#define MK_ATT_DBG 0
#endif
#ifndef MK_REP_PHASE
#define MK_REP_PHASE -1
#endif
#define IN(k) ((ONLY_PHASE < 0 || ONLY_PHASE == (k)) && lo <= (k) && (k) < hi)
#ifndef MK_TS
#define MK_TS -1
#endif
    unsigned long long ts0 = 0, ts1 = 0;
#define SEAM(k) do { if (IN(k) && IN((k) + 1)) xcd_barrier(bar, F.wave == 0 && lane_id() == 0); if (MK_TS == (k) + 1) ts0 = __builtin_amdgcn_s_memrealtime(); if (MK_TS == (k)) ts1 = __builtin_amdgcn_s_memrealtime(); } while (0)
    if (MK_TS == 0) ts0 = __builtin_amdgcn_s_memrealtime();

#ifdef MK_XBAR
    if (lo == 0 && hi == NPHASE) for (int xb_ = 0; xb_ < MK_XBAR; ++xb_) xcd_barrier(bar, F.wave == 0 && lane_id() == 0);
#endif
    if (IN(0)) { p0_prologue(F); }
    SEAM(0);
    if (IN(1)) {
        StaticOrder S; S.init(ws + WS_XN, ws + WS_WIN, M, NZP, 2 * D, F.G, (int)blockIdx.x);
        EpiWin E{(bf16*)(ws + WS_Q), (bf16*)(ws + WS_KCH), (bf16*)(ws + WS_VCH), (bf16*)(ws + WS_KS), (bf16*)(ws + WS_VS), (bf16*)(ws + WS_KW), (bf16*)(ws + WS_VW),
                 (bf16*)(ws + WS_U), (bf16*)(ws + WS_VG), (float*)(ws + WS_GATES), (float*)(ws + WS_VSSQ), fin(F, 3), fin(F, 4), DBG == 4 ? 1 : 0};
        pg8::gemm_phase<EpiWin, StaticOrder, true, false>(F.lds, 2 * D, S, E, F.wave);
        if ((int)blockIdx.x >= 128 && F.G == 256) p0_convert(F, (LAS char*)(F.lds + F.wave * 16384), CV_A0, CV_A1, ((int)blockIdx.x - 128) * NWAVES + F.wave, 128 * NWAVES);
        else if (F.G != 256) p0_convert(F, (LAS char*)(F.lds + F.wave * 16384), CV_A0, CV_A1, F.vcu * NWAVES + F.wave, F.G * NWAVES);
    }
    SEAM(1);
    if (IN(2)) {
        gmlp_phase(F);
        CmpOrder S; S.idx = F.vcu - 128; S.A0 = (const char*)(ws + WS_KCH); S.A1 = (const char*)(ws + WS_VCH); S.B = (const char*)(ws + WS_WCMP);
        EpiCmp E{(float*)(ws + WS_TCMP)};
        pg8::gemm_phase<EpiCmp, CmpOrder, false, false>(F.lds, 2048, S, E, F.wave);
        if (F.vcu >= 144 && F.G == 256) p0_convert(F, (LAS char*)(F.lds + F.wave * 16384), CV_A1, CV_A2, (F.vcu - 144) * NWAVES + F.wave, 112 * NWAVES);
        else if (F.G != 256) p0_convert(F, (LAS char*)(F.lds + F.wave * 16384), CV_A1, CV_A2, F.vcu * NWAVES + F.wave, F.G * NWAVES);
    }
    SEAM(2);
    if (IN(3)) { cmp2_phase(F); p0_convert(F, (LAS char*)(F.lds + F.wave * 16384), CV_A2, CV_A3, F.vcu * NWAVES + F.wave, F.G * NWAVES); }
    SEAM(3);
    if (IN(4)) { attn_phase<DBG>(F, args.dbg); if (!args.dbg && DBG < 5) attn_tail_convert(F); }
    SEAM(4);
    if (IN(5)) {
        StaticOrder S; S.init(ws + WS_MIXED, ws + WS_WOUT, M, D, 2 * D, F.G, (int)blockIdx.x);
        EpiWout E{fin(F, 0), ws + WS_X1H, ws + WS_X1B};
        pg8::gemm_phase<EpiWout, StaticOrder, true, false>(F.lds, 2 * D, S, E, F.wave);
    }
    SEAM(5);
    if (IN(6)) { route_phase<DBG>(F); if (CV_LATE > 0) p0_convert(F, (LAS char*)(F.lds + F.wave * 16384), P0_MOE - CV_LATE, P0_MOE, F.vcu * NWAVES + F.wave, F.G * NWAVES); }
    SEAM(6);
    LAS int* tstart = nullptr; LAS int* ecnt = nullptr;
    if (IN(7)) {
        moe_tables(F, tstart, ecnt);
        MoeOrder<8, true, DBG> S; S.G = F.G; S.c = (int)blockIdx.x; S.utot = tstart[32] * 8; S.tstart = tstart; S.ecnt = ecnt;
        S.A = (const char*)(ws + WS_X1B); S.B = (const char*)(ws + WS_WGU); S.bexp = (size_t)2048 * 1024; S.list = (const int*)(ws + WS_LIST); S.stash = F.lds + AUX_OFF; S.dbg = args.dbg;
        EpiG1T<DBG> E{ws + (DBG ? WS_O2 : WS_H), fin(F, 20), (const int*)(ws + WS_LIST), 0};
        pg8::gemm_phase<EpiG1T<DBG>, MoeOrder<8, true, DBG>, true, true>(F.lds, 1024, S, E, F.wave);
    }
    SEAM(7);
    if (IN(8)) {
        moe_tables(F, tstart, ecnt);
        MoeOrder<4, false> S; S.G = F.G; S.c = (int)blockIdx.x; S.utot = tstart[32] * 4; S.tstart = tstart; S.ecnt = ecnt;
        S.A = (const char*)(ws + WS_H); S.B = (const char*)(ws + WS_WD); S.bexp = (size_t)1024 * 1024; S.list = nullptr; S.stash = nullptr; S.dbg = 0;
        EpiG2 E{ws + WS_O2, fin(F, 22)};
        pg8::gemm_phase<EpiG2, MoeOrder<4, false>, true, true>(F.lds, 1024, S, E, F.wave);
    }
    SEAM(8);
    if (IN(9)) { moe_tables(F, tstart, ecnt); final_phase<DBG>(F, tstart); }
    if (lo == 10) { const float* wsrc = fin(F, 19); const int gw = F.vcu * NWAVES + F.wave, lane = lane_id(); f32x4 accf = {0.f, 0.f, 0.f, 0.f};
        for (size_t i = (size_t)gw * 64 + lane; i < (size_t)32 * 1024 * 2048 / 4; i += (size_t)F.G * NWAVES * 64) accf += *(const f32x4*)(wsrc + i * 4);
        if (accf.x == 1.2345f) F.out[0] = accf.y; }
    if (MK_TS >= 0) { if (MK_TS == 9) ts1 = __builtin_amdgcn_s_memrealtime();
        if (blockIdx.x == 0 && F.wave == 0 && lane_id() == 0) { asm volatile("s_waitcnt vmcnt(0)" ::: "memory"); F.out[0] += (float)(ts1 - ts0); } }
#undef IN
#undef SEAM
}

#define mk_fwd mk_fwd_t<0>
#ifndef MK_KDBG
#define MK_KDBG 0
#endif
extern "C" void kernel_launch(void* const* d_in, const int* in_sizes, int n_in, void* d_out, int out_size, void* d_ws, size_t ws_size, hipStream_t stream) {
    static int grid = 0;
    if (grid == 0) {
        if (n_in != 23 || out_size != M * D || ws_size < WS_END) { fprintf(stderr, "kernel_launch: unexpected shapes (n_in %d out %d ws %zu)\n", n_in, out_size, ws_size); grid = -1; return; }
        int dev = 0, cus = 0, per_cu = 0;
        hipGetDevice(&dev); hipDeviceGetAttribute(&cus, hipDeviceAttributeMultiprocessorCount, dev);
        if (hipFuncSetAttribute((const void*)mk_fwd, hipFuncAttributeMaxDynamicSharedMemorySize, LDS_BYTES) != hipSuccess) { fprintf(stderr, "kernel_launch: hipFuncSetAttribute failed\n"); grid = -1; return; }
        hipOccupancyMaxActiveBlocksPerMultiprocessor(&per_cu, (const void*)mk_fwd, NWAVES * 64, LDS_BYTES);
        (void)hipGetLastError();
        if (per_cu < 1) { fprintf(stderr, "kernel_launch: occupancy query says %d blocks per CU\n", per_cu); grid = -1; return; }
        grid = cus;
    }
    if (grid < 0) return;
    hipMemsetAsync((char*)d_ws + WS_CTL, 0, CTL_ZERO_BYTES, stream);
    Args a{};
    for (int i = 0; i < 23; ++i) a.in[i] = (const float*)d_in[i];
    a.out = (float*)d_out; a.ws = (unsigned char*)d_ws;
#if MK_SPLIT
    for (int p = 0; p < NPHASE; ++p) { a.ph_lo = p; a.ph_hi = p + 1; hipLaunchKernelGGL(mk_fwd, dim3(grid), dim3(NWAVES * 64), LDS_BYTES, stream, a);
        if (p == MK_REP_PHASE) { a.dbg = MK_ATT_DBG;
#ifdef MK_FLUSH
            { Args f = a; f.ph_lo = 10; f.ph_hi = 11; hipLaunchKernelGGL(mk_fwd, dim3(grid), dim3(NWAVES * 64), LDS_BYTES, stream, f); }
#if MK_FLUSH == 2
            a.dbg = 0; continue;
#endif
#endif
            if (MK_KDBG) { hipFuncSetAttribute((const void*)mk_fwd_t<MK_KDBG>, hipFuncAttributeMaxDynamicSharedMemorySize, LDS_BYTES); hipLaunchKernelGGL(mk_fwd_t<MK_KDBG>, dim3(grid), dim3(NWAVES * 64), LDS_BYTES, stream, a); } else hipLaunchKernelGGL(mk_fwd, dim3(grid), dim3(NWAVES * 64), LDS_BYTES, stream, a); a.dbg = 0; } }
#else
    a.ph_lo = 0; a.ph_hi = NPHASE;
    void* kargs[] = {&a};
#ifdef MK_PLAIN
    (void)kargs; hipLaunchKernelGGL(mk_fwd, dim3(grid), dim3(NWAVES * 64), LDS_BYTES, stream, a); hipError_t e = hipPeekAtLastError();
#else
    hipError_t e = hipLaunchCooperativeKernel((const void*)mk_fwd, dim3(grid), dim3(NWAVES * 64), kargs, LDS_BYTES, stream);
#endif
    if (e != hipSuccess) fprintf(stderr, "kernel_launch: cooperative launch failed: %s (grid %d)\n", hipGetErrorString(e), grid);
#endif
}
```
